# Optimizing an MI355X kernel written in HIP

```python
import jax
import jax.numpy as jnp
from jax import lax
import numpy as np

D_MODEL = 1024
BATCH = 2
SEQ = 8192
DEPTH = 1

HEAD_DIM = 64
N_HEADS = D_MODEL // HEAD_DIM
N_HEADS_SB = N_HEADS // 2
N_HEADS_DIL = N_HEADS - N_HEADS_SB
D_SB = N_HEADS_SB * HEAD_DIM
D_DIL = N_HEADS_DIL * HEAD_DIM
D_IN = 3 * D_SB + 3 * D_DIL
D_FF = 2816
DILATED_PATTERNS = ((128, 1), (512, 4), (2048, 16))
BLOCK = 128
ROPE_THETA = 10000.0
RMS_EPS = 1e-6
HALF_STEP = 0.5

kernel_name = 'hybrid_stickbreak_dilated_macaron'


def rmsnorm(x, gain):
    xf = x.astype(jnp.float32)
    y = xf * lax.rsqrt(jnp.mean(xf * xf, axis=-1, keepdims=True) + RMS_EPS)
    return (y * gain.astype(jnp.float32)).astype(x.dtype)


def swiglu(x, w_gate, w_up, w_down):
    return (jax.nn.silu(x @ w_gate) * (x @ w_up)) @ w_down


def rotary(t, positions):
    half = t.shape[-1] // 2
    inv_freq = ROPE_THETA ** (-jnp.arange(half, dtype=jnp.float32) / half)
    ang = positions.astype(jnp.float32)[:, None] * inv_freq[None, :]
    cos, sin = jnp.cos(ang), jnp.sin(ang)
    tf = t.astype(jnp.float32)
    t1, t2 = tf[..., :half], tf[..., half:]
    return jnp.concatenate([t1 * cos - t2 * sin, t2 * cos + t1 * sin], axis=-1).astype(t.dtype)


def split_heads(t, n_heads):
    b, s, _ = t.shape
    return t.reshape(b, s, n_heads, HEAD_DIM).transpose(0, 2, 1, 3)


def merge_heads(t):
    b, h, s, d = t.shape
    return t.transpose(0, 2, 1, 3).reshape(b, s, h * d)


def stick_breaking_attention(q, k, v):
    b, h, s, d = q.shape
    nb = s // BLOCK
    scale = d ** -0.5
    qb = q.reshape(b, h, nb, BLOCK, d).transpose(2, 0, 1, 3, 4)
    key_pos = jnp.arange(s)

    def one_block(args):
        q_blk, blk = args
        q_pos = blk * BLOCK + jnp.arange(BLOCK)
        z = jnp.einsum('bhqd,bhkd->bhqk', q_blk, k, preferred_element_type=jnp.float32) * scale
        mask = key_pos[None, :] < q_pos[:, None]
        log_beta = jax.nn.log_sigmoid(z)
        log_stay = jnp.where(mask, jax.nn.log_sigmoid(-z), 0.0)
        later = lax.cumsum(log_stay, axis=3, reverse=True) - log_stay
        weights = jnp.where(mask, jnp.exp(log_beta + later), 0.0)
        return jnp.einsum('bhqk,bhkd->bhqd', weights.astype(v.dtype), v)

    out = lax.map(one_block, (qb, jnp.arange(nb)))
    return out.transpose(1, 2, 0, 3, 4).reshape(b, h, s, d)


def _dilated_pattern(q, k, v, window, dilation):
    b, h, s, d = q.shape
    span = window // dilation
    n_comp = s // dilation
    nb = n_comp // BLOCK

    def to_blocks(t):
        t = t.reshape(b, h, n_comp, dilation, d).transpose(0, 1, 3, 2, 4)
        return t.reshape(b, h, dilation, nb, BLOCK, d)

    def with_previous(t):
        prev = jnp.pad(t, ((0, 0), (0, 0), (0, 0), (1, 0), (0, 0), (0, 0)))[:, :, :, :-1]
        return jnp.concatenate([prev, t], axis=4)

    qb = to_blocks(q)
    kb = with_previous(to_blocks(k))
    vb = with_previous(to_blocks(v))
    z = jnp.einsum('bhcnqd,bhcnkd->bhcnqk', qb, kb, preferred_element_type=jnp.float32) * (d ** -0.5)
    q_idx = jnp.arange(BLOCK)[:, None] + BLOCK
    k_idx = jnp.arange(2 * BLOCK)[None, :]
    dist = q_idx - k_idx
    band = (dist >= 0) & (dist <= span)
    has_prev = (jnp.arange(nb) > 0)[:, None, None] | (k_idx >= BLOCK)[None]
    valid = band[None] & has_prev
    z = jnp.where(valid, z, -jnp.inf)
    m = jnp.max(z, axis=-1, keepdims=True)
    p = jnp.exp(z - m)
    denom = jnp.sum(p, axis=-1, keepdims=True)
    o = jnp.einsum('bhcnqk,bhcnkd->bhcnqd', p, vb.astype(jnp.float32)) / denom
    lse = m + jnp.log(denom)

    def from_blocks(t):
        e = t.shape[-1]
        t = t.reshape(b, h, dilation, n_comp, e).transpose(0, 1, 3, 2, 4)
        return t.reshape(b, h, s, e)

    return from_blocks(o), from_blocks(lse)


def dilated_mixture_attention(q, k, v):
    s = q.shape[2]
    outs, lses = [], []
    for window, dilation in DILATED_PATTERNS:
        unit = BLOCK * dilation
        s_pad = -(-s // unit) * unit
        pad = ((0, 0), (0, 0), (0, s_pad - s), (0, 0))
        o, lse = _dilated_pattern(jnp.pad(q, pad), jnp.pad(k, pad), jnp.pad(v, pad), window, dilation)
        outs.append(o[:, :, :s])
        lses.append(lse[:, :, :s])
    alpha = jax.nn.softmax(jnp.stack(lses), axis=0)
    return jnp.sum(alpha * jnp.stack(outs), axis=0).astype(q.dtype)


def token_mixer(h, w_in, sb_out_norm, dil_out_norm, w_out):
    seq = h.shape[1]
    proj = h @ w_in
    cuts = [D_SB, 2 * D_SB, 3 * D_SB, 3 * D_SB + D_DIL, 3 * D_SB + 2 * D_DIL]
    q_sb, k_sb, v_sb, q_dl, k_dl, v_dl = jnp.split(proj, cuts, axis=-1)
    positions = jnp.arange(seq)
    o_sb = stick_breaking_attention(split_heads(q_sb, N_HEADS_SB), split_heads(k_sb, N_HEADS_SB),
                                    split_heads(v_sb, N_HEADS_SB))
    o_dl = dilated_mixture_attention(rotary(split_heads(q_dl, N_HEADS_DIL), positions),
                                     rotary(split_heads(k_dl, N_HEADS_DIL), positions),
                                     split_heads(v_dl, N_HEADS_DIL))
    merged = jnp.concatenate([rmsnorm(merge_heads(o_sb), sb_out_norm),
                              rmsnorm(merge_heads(o_dl), dil_out_norm)], axis=-1)
    return merged @ w_out


def setup_inputs(seed: int = 0) -> dict:
    key = jax.random.key(seed)
    ks = jax.random.split(key, 16)

    def normal(k, shape, scale):
        return jax.random.normal(k, shape, jnp.float32) * scale

    def gain(k, shape):
        return 1.0 + 0.02 * jax.random.normal(k, shape, jnp.float32)

    dm, df = D_MODEL ** -0.5, D_FF ** -0.5
    return {
        'x': normal(ks[0], (BATCH, SEQ, D_MODEL), 1.0),
        'ffn1_norm': gain(ks[1], (DEPTH, D_MODEL)),
        'ffn1_w_gate': normal(ks[2], (DEPTH, D_MODEL, D_FF), dm),
        'ffn1_w_up': normal(ks[3], (DEPTH, D_MODEL, D_FF), dm),
        'ffn1_w_down': normal(ks[4], (DEPTH, D_FF, D_MODEL), df),
        'mix_norm': gain(ks[5], (DEPTH, D_MODEL)),
        'w_in': normal(ks[6], (DEPTH, D_MODEL, D_IN), dm),
        'sb_out_norm': gain(ks[7], (DEPTH, D_SB)),
        'dil_out_norm': gain(ks[8], (DEPTH, D_DIL)),
        'w_out': normal(ks[9], (DEPTH, D_MODEL, D_MODEL), dm),
        'ffn2_norm': gain(ks[10], (DEPTH, D_MODEL)),
        'ffn2_w_gate': normal(ks[11], (DEPTH, D_MODEL, D_FF), dm),
        'ffn2_w_up': normal(ks[12], (DEPTH, D_MODEL, D_FF), dm),
        'ffn2_w_down': normal(ks[13], (DEPTH, D_FF, D_MODEL), df),
        'final_norm': gain(ks[14], (D_MODEL,)),
    }


def reference(x, ffn1_norm, ffn1_w_gate, ffn1_w_up, ffn1_w_down, mix_norm, w_in, sb_out_norm,
              dil_out_norm, w_out, ffn2_norm, ffn2_w_gate, ffn2_w_up, ffn2_w_down, final_norm):
    for layer in range(DEPTH):
        x = x + HALF_STEP * swiglu(rmsnorm(x, ffn1_norm[layer]), ffn1_w_gate[layer],
                                   ffn1_w_up[layer], ffn1_w_down[layer])
        x = x + token_mixer(rmsnorm(x, mix_norm[layer]), w_in[layer], sb_out_norm[layer],
                            dil_out_norm[layer], w_out[layer])
        x = x + HALF_STEP * swiglu(rmsnorm(x, ffn2_norm[layer]), ffn2_w_gate[layer],
                                   ffn2_w_up[layer], ffn2_w_down[layer])
    return rmsnorm(x, final_norm)
```

```cpp
#include <hip/hip_runtime.h>
#include <hip/hip_cooperative_groups.h>
#include <cstdio>
#include <cstdint>
#include <cmath>
namespace cg = cooperative_groups;
namespace pg8 {
#define PG8_LAS __attribute__((address_space(3)))
typedef unsigned short bf16_t;
typedef short bf16x8 __attribute__((ext_vector_type(8)));
typedef float f32x4 __attribute__((ext_vector_type(4)));
typedef unsigned u32x4 __attribute__((ext_vector_type(4)));
constexpr int BM = 256, BK = 64, HALF = 128, HTB = HALF * BK * 2  , STAGE_BYTES = 8 * HTB, NXCD = 8, WGM = 8;

__host__ __device__ __forceinline__ int lds_byte(int r, int c) { const int st = (r >> 4) * 2 + (c >> 5), rr = r & 15, cc = c & 31, ob = rr * 64 + cc * 2; return st * 1024 + (ob ^ (((ob >> 9) & 1) << 5)); }
__host__ __device__ __forceinline__ void stage_rc(int b, int& R, int& C) { const int st = b / 1024, sb = b % 1024, swz = sb ^ (((sb >> 9) & 1) << 5); R = (st >> 1) * 16 + swz / 64; C = (st & 1) * 32 + (swz % 64) / 2; }
__host__ __device__ __forceinline__ int perm32(int rho) { const int n = rho >> 4, i = rho & 15; return 8 * (i >> 2) + 4 * n + (i & 3); }

struct Unit { int pm, pn; };
struct Gemm { const bf16_t* A; const bf16_t* Bt; int M, N, K; };

struct StaticOrder {
    int nM, nN, nwg, G, c;
    __host__ __device__ void init(int M, int N, int G_, int c_) { nM = M / BM; nN = N / BM; nwg = nM * nN; G = G_; c = c_; }
    __host__ __device__ bool next(int i, Unit& u) const {
        const long L = (long)i * G + c; if (L >= nwg) return false;
        int wgid = (int)L; { const int q = nwg / NXCD, r = nwg % NXCD, xcd = wgid % NXCD, off = wgid / NXCD; wgid = (xcd < r ? xcd * (q + 1) : r * (q + 1) + (xcd - r) * q) + off; }
        const int nig = WGM * nN, gid = wgid / nig, fm = gid * WGM, gsz = (nM - fm) < WGM ? (nM - fm) : WGM;
        u.pm = fm + ((wgid % nig) % gsz); u.pn = (wgid % nig) / gsz; return true;
    }
    __device__ __forceinline__ void a_ready(const Unit&) const {}
    __device__ __forceinline__ void done(const Unit&) const {}
};

__device__ __forceinline__ unsigned cvt_pk_bf16(float lo, float hi) { unsigned r; asm volatile("v_cvt_pk_bf16_f32 %0, %1, %2" : "=v"(r) : "v"(lo), "v"(hi)); return r; }
typedef float f32x2 __attribute__((ext_vector_type(2)));
template <class Epi, class Sched, bool ALIGN_EPI = false, bool SP2 = false>
__device__ __forceinline__ void gemm_phase(PG8_LAS unsigned char* lds, const Gemm g, const Sched& S, const Epi& E) {
    const int tid = threadIdx.x, wid = __builtin_amdgcn_readfirstlane(tid >> 6), lane = tid & 63, wr = wid >> 2, wc = wid & 3, fr = lane & 15, fq = lane >> 4;
    const int K = g.K, nt = K / BK;
    unsigned voffA[2], voffB[2];
#pragma unroll
    for (int i = 0; i < 2; ++i) { int R, C; stage_rc(tid * 16 + i * 8192, R, C); const int Rb = Epi::PERM ? ((R & ~31) + perm32(R & 31)) : R;
        voffA[i] = (unsigned)(R * K + C) * 2u; voffB[i] = (unsigned)(Rb * K + C) * 2u; }
    const size_t kstep = (size_t)(BK * 2);
    const size_t hstep = (size_t)HALF * K * 2;
    const size_t tstep = 2 * hstep;
    const unsigned ldsw = (unsigned)wid * 1024u;
    const int aoff = lds_byte(wr * 64 + fr, fq * 8), boff = lds_byte(wc * 32 + fr, fq * 8);
#define PG8_SA(b, h) (((b) * 2 + (h)) * HTB)
#define PG8_SB(b, h) ((4 + (b) * 2 + (h)) * HTB)
#define PG8_STAGE(bufoff, gbase, voff) do { _Pragma("unroll") for (int _i = 0; _i < 2; ++_i) \
        __builtin_amdgcn_global_load_lds((const unsigned*)((const char*)(gbase) + (voff)[_i]), (PG8_LAS unsigned*)(lds + (bufoff) + ldsw + _i * 8192), 16, 0, 0); } while (0)
#define PG8_LDA(dst, b, h) do { _Pragma("unroll") for (int m = 0; m < 4; ++m) _Pragma("unroll") for (int k = 0; k < 2; ++k) dst[m][k] = *(const PG8_LAS bf16x8*)(lds + PG8_SA(b, h) + aoff + m * 2048 + k * 1024); } while (0)
#define PG8_LDB(dst, b, h) do { _Pragma("unroll") for (int n = 0; n < 2; ++n) _Pragma("unroll") for (int k = 0; k < 2; ++k) dst[n][k] = *(const PG8_LAS bf16x8*)(lds + PG8_SB(b, h) + boff + n * 2048 + k * 1024); } while (0)
#define PG8_MMA(ai, bj, At, Bt) do { __builtin_amdgcn_s_setprio(1); _Pragma("unroll") for (int m = 0; m < 4; ++m) _Pragma("unroll") for (int n = 0; n < 2; ++n) _Pragma("unroll") for (int k = 0; k < 2; ++k) \
        acc[ai][bj][m][n] = __builtin_amdgcn_mfma_f32_16x16x32_bf16(Bt[n][k], At[m][k], acc[ai][bj][m][n], 0, 0, 0); __builtin_amdgcn_s_setprio(0); } while (0)
#define PG8_WAIT_V(n) asm volatile("s_waitcnt vmcnt(" #n ")" ::: "memory")
#define PG8_WAIT_L(n) asm volatile("s_waitcnt lgkmcnt(" #n ")" ::: "memory")
#define PG8_BAR __builtin_amdgcn_s_barrier()
#define PG8_SCHED __builtin_amdgcn_sched_barrier(0)
    Unit cur, nxt; int ui = 0;
    if (!S.next(0, cur)) return;
    f32x4 acc[2][2][4][2];
#pragma unroll
    for (int a = 0; a < 2; ++a)
#pragma unroll
        for (int b = 0; b < 2; ++b)
#pragma unroll
            for (int m = 0; m < 4; ++m)
#pragma unroll
                for (int n = 0; n < 2; ++n) acc[a][b][m][n] = (f32x4){0.f, 0.f, 0.f, 0.f};
    bf16x8 At[4][2], B0[2][2], B1[2][2];
    const char* cA = (const char*)g.A + (size_t)cur.pm * tstep; const char* cB = (const char*)g.Bt + (size_t)cur.pn * tstep;
    S.a_ready(cur);
    if constexpr (SP2) {
        PG8_STAGE(PG8_SB(0, 0), cB, voffB); PG8_STAGE(PG8_SB(0, 1), cB + hstep, voffB); PG8_STAGE(PG8_SA(0, 0), cA, voffA); PG8_STAGE(PG8_SA(0, 1), cA + hstep, voffA);
        if (wr == 1) PG8_BAR;
        PG8_WAIT_V(2); PG8_BAR;
        PG8_STAGE(PG8_SB(1, 0), cB + kstep, voffB); PG8_STAGE(PG8_SA(1, 0), cA + kstep, voffA); PG8_STAGE(PG8_SB(1, 1), cB + hstep + kstep, voffB);
        PG8_WAIT_V(6); PG8_BAR;
    } else {
        PG8_STAGE(PG8_SB(0, 0), cB, voffB); PG8_STAGE(PG8_SA(0, 0), cA, voffA); PG8_STAGE(PG8_SB(0, 1), cB + hstep, voffB); PG8_STAGE(PG8_SA(0, 1), cA + hstep, voffA);
        if (wr == 1) PG8_BAR;
        PG8_WAIT_V(4); PG8_BAR;
        PG8_STAGE(PG8_SB(1, 0), cB + kstep, voffB); PG8_STAGE(PG8_SA(1, 0), cA + kstep, voffA); PG8_STAGE(PG8_SB(1, 1), cB + hstep + kstep, voffB);
        PG8_WAIT_V(6); PG8_BAR;
    }
    for (;;) {
        const bool has_next = S.next(ui + 1, nxt);
        const char* nA = has_next ? (const char*)g.A + (size_t)nxt.pm * tstep : cA; const char* nB = has_next ? (const char*)g.Bt + (size_t)nxt.pn * tstep : cB;
        for (int t = 0; t < nt; t += 2) {
            const bool last = (t == nt - 2);
            const char* a1 = cA + (size_t)(t + 1) * kstep;
            const char* a2 = last ? nA : cA + (size_t)(t + 2) * kstep; const char* b2 = last ? nB : cB + (size_t)(t + 2) * kstep;
            const char* a3 = a2 + kstep; const char* b3 = b2 + kstep;
            if (last && has_next) S.a_ready(nxt);
            if constexpr (SP2) {
            PG8_LDB(B0, 0, 0); PG8_LDB(B1, 0, 1); PG8_SCHED; PG8_LDA(At, 0, 0); PG8_STAGE(PG8_SA(1, 1), a1 + hstep, voffA);
            PG8_WAIT_V(8); PG8_WAIT_L(0); PG8_BAR; PG8_MMA(0, 0, At, B0); PG8_MMA(0, 1, At, B1); PG8_BAR; PG8_SCHED;
            PG8_LDA(At, 0, 1); PG8_STAGE(PG8_SB(0, 0), b2, voffB); PG8_STAGE(PG8_SB(0, 1), b2 + hstep, voffB); PG8_STAGE(PG8_SA(0, 0), a2, voffA);
            PG8_WAIT_V(8); PG8_WAIT_L(0); PG8_BAR; PG8_MMA(1, 0, At, B0); PG8_MMA(1, 1, At, B1); PG8_BAR; PG8_SCHED;
            PG8_LDB(B0, 1, 0); PG8_LDB(B1, 1, 1); PG8_SCHED; PG8_LDA(At, 1, 0); PG8_STAGE(PG8_SA(0, 1), a2 + hstep, voffA);
            PG8_WAIT_V(8); PG8_WAIT_L(0); PG8_BAR; PG8_MMA(0, 0, At, B0); PG8_MMA(0, 1, At, B1); PG8_BAR; PG8_SCHED;
            PG8_LDA(At, 1, 1); PG8_STAGE(PG8_SB(1, 0), b3, voffB); PG8_STAGE(PG8_SB(1, 1), b3 + hstep, voffB); PG8_STAGE(PG8_SA(1, 0), a3, voffA);
            PG8_WAIT_V(8); PG8_WAIT_L(0); PG8_BAR; PG8_MMA(1, 0, At, B0); PG8_MMA(1, 1, At, B1); PG8_BAR; PG8_SCHED;
            } else {
            PG8_LDB(B0, 0, 0); PG8_SCHED; PG8_LDA(At, 0, 0); PG8_STAGE(PG8_SA(1, 1), a1 + hstep, voffA);
            PG8_WAIT_L(8); PG8_BAR; PG8_WAIT_L(0); PG8_MMA(0, 0, At, B0); PG8_BAR; PG8_SCHED;
            PG8_LDB(B1, 0, 1); PG8_STAGE(PG8_SB(0, 0), b2, voffB);
            PG8_BAR; PG8_WAIT_L(0); PG8_MMA(0, 1, At, B1); PG8_BAR;
            PG8_LDA(At, 0, 1); PG8_STAGE(PG8_SA(0, 0), a2, voffA);
            PG8_BAR; PG8_WAIT_L(0); PG8_MMA(1, 0, At, B0); PG8_BAR; PG8_SCHED;
            PG8_STAGE(PG8_SB(0, 1), b2 + hstep, voffB);
            PG8_WAIT_V(6); PG8_BAR; PG8_MMA(1, 1, At, B1); PG8_BAR;
            PG8_LDB(B0, 1, 0); PG8_SCHED; PG8_LDA(At, 1, 0); PG8_STAGE(PG8_SA(0, 1), a2 + hstep, voffA);
            PG8_WAIT_L(8); PG8_BAR; PG8_WAIT_L(0); PG8_MMA(0, 0, At, B0); PG8_BAR; PG8_SCHED;
            PG8_LDB(B1, 1, 1); PG8_STAGE(PG8_SB(1, 0), b3, voffB);
            PG8_BAR; PG8_WAIT_L(0); PG8_MMA(0, 1, At, B1); PG8_BAR;
            PG8_LDA(At, 1, 1); PG8_STAGE(PG8_SA(1, 0), a3, voffA);
            PG8_BAR; PG8_WAIT_L(0); PG8_MMA(1, 0, At, B0); PG8_BAR; PG8_SCHED;
            PG8_STAGE(PG8_SB(1, 1), b3 + hstep, voffB);
            PG8_WAIT_V(6); PG8_BAR; PG8_MMA(1, 1, At, B1); PG8_BAR;
            }
        }
        if constexpr (ALIGN_EPI) { if (wr == 0) PG8_BAR; }
        if constexpr (!Epi::AFTER_DRAIN) { E(acc, cur, wr, wc, fr, fq); S.done(cur); }
        if (!has_next) break;
#pragma unroll
        for (int a = 0; a < 2; ++a)
#pragma unroll
            for (int b = 0; b < 2; ++b)
#pragma unroll
                for (int m = 0; m < 4; ++m)
#pragma unroll
                    for (int n = 0; n < 2; ++n) acc[a][b][m][n] = (f32x4){0.f, 0.f, 0.f, 0.f};
        cur = nxt; cA = nA; cB = nB; ++ui;
        if constexpr (ALIGN_EPI) { if (wr == 1) PG8_BAR; }
    }
    PG8_WAIT_V(0);
    if constexpr (!ALIGN_EPI) { if (wr == 0) PG8_BAR; }
    PG8_BAR;
    if constexpr (Epi::AFTER_DRAIN) { E.fused(acc, cur, wr, wc, fr, fq, lds, wid, lane); S.done(cur); }
#undef PG8_SA
#undef PG8_SB
#undef PG8_STAGE
#undef PG8_LDA
#undef PG8_LDB
#undef PG8_MMA
#undef PG8_WAIT_V
#undef PG8_WAIT_L
#undef PG8_BAR
#undef PG8_SCHED
}
}

namespace pg8 {
constexpr float RMS_EPS = 1e-6f;
constexpr float C2 = 0.125f * 1.4426950408889634f;
typedef __bf16 bf16x2_t __attribute__((ext_vector_type(2)));
__device__ __forceinline__ unsigned pkbf(float lo, float hi) { f32x2 v = {lo, hi}; bf16x2_t b = __builtin_convertvector(v, bf16x2_t); return __builtin_bit_cast(unsigned, b); }
__device__ __forceinline__ float rstd_row(const float* ss, int row, float inv_n) { return __builtin_amdgcn_rsqf(ss[row] * inv_n + RMS_EPS); }

struct EpiSwiGLU {
    static constexpr bool PERM = true, AFTER_DRAIN = false;
    bf16_t* H; const float* ss; int ldh;
    __device__ __forceinline__ void operator()(const f32x4 (&acc)[2][2][4][2], const Unit& u, int wr, int wc, int fr, int fq) const {
        const int row0 = u.pm * BM + wr * 64 + fr, col0 = u.pn * HALF + wc * 32 + 8 * fq;
#pragma unroll
        for (int ai = 0; ai < 2; ++ai)
#pragma unroll
            for (int m = 0; m < 4; ++m) { const int row = row0 + ai * HALF + m * 16; const float r = rstd_row(ss, row, 1.0f / 1024.0f);
                u32x4 w;
#pragma unroll
                for (int n = 0; n < 2; ++n) { const f32x4 g = acc[ai][0][m][n] * r, up = acc[ai][1][m][n] * r; float hv[4];
#pragma unroll
                    for (int e = 0; e < 4; ++e) { const float sg = g[e] * __builtin_amdgcn_rcpf(1.0f + __builtin_amdgcn_exp2f(-1.4426950408889634f * g[e])); hv[e] = sg * up[e]; }
                    w[2 * n] = pkbf(hv[0], hv[1]); w[2 * n + 1] = pkbf(hv[2], hv[3]); }
                *(u32x4*)(H + (size_t)row * ldh + col0) = w; }
    }
};
template <bool WXB> struct EpiResid {
    static constexpr bool PERM = false, AFTER_DRAIN = false;
    const float* xin; float* xout; bf16_t* xb; float* ss; float alpha;
    __device__ __forceinline__ void operator()(const f32x4 (&acc)[2][2][4][2], const Unit& u, int wr, int wc, int fr, int fq) const {
        typedef unsigned u32x2v __attribute__((ext_vector_type(2)));
        const int row0 = u.pm * BM + wr * 64 + fr, col0 = u.pn * BM + wc * 32 + 4 * fq;
#pragma unroll
        for (int ai = 0; ai < 2; ++ai)
#pragma unroll
            for (int m = 0; m < 4; ++m) { const int row = row0 + ai * HALF + m * 16; const size_t off = (size_t)row * 1024 + col0; float q = 0.f;
#pragma unroll
                for (int bj = 0; bj < 2; ++bj)
#pragma unroll
                    for (int n = 0; n < 2; ++n) { const f32x4 b = *(const f32x4*)(xin + off + bj * HALF + n * 16); const f32x4 v = b + acc[ai][bj][m][n] * alpha;
                        *(f32x4*)(xout + off + bj * HALF + n * 16) = v; q += (v[0] * v[0] + v[1] * v[1]) + (v[2] * v[2] + v[3] * v[3]);
                        if (WXB) { u32x2v w; w.x = pkbf(v[0], v[1]); w.y = pkbf(v[2], v[3]); *(u32x2v*)(xb + off + bj * HALF + n * 16) = w; } }
                q += __shfl_xor(q, 16); q += __shfl_xor(q, 32);
                if (fq == 0) atomicAdd(ss + row, q); }
    }
};
__device__ __forceinline__ void sincos_big(float ang, float& s, float& c) {
    const float CH = 0.15915493667125702f, CL = 6.4206382432985265e-09f;
    const float hi = ang * CH; const float lo = __builtin_fmaf(ang, CH, -hi) + ang * CL;
    const float x = __builtin_amdgcn_fractf(hi) + lo;
    s = __builtin_amdgcn_sinf(x); c = __builtin_amdgcn_cosf(x);
}
struct EpiQKV {
    static constexpr bool PERM = true, AFTER_DRAIN = false;
    bf16_t* O; const float* ss;
    __device__ __forceinline__ void operator()(const f32x4 (&acc)[2][2][4][2], const Unit& u, int wr, int wc, int fr, int fq) const {
        const int type = u.pn >> 1; const float qs = (type == 0 || type == 3) ? C2 : 1.0f;
        const int row0 = u.pm * BM + wr * 64 + fr;
        if (type == 3 || type == 4) {
            float invf[8];
#pragma unroll
            for (int j = 0; j < 8; ++j) invf[j] = exp2f(-(float)(8 * fq + j) * 0.4152410118609203f);
            const int col0 = u.pn * BM + wc * 64 + 8 * fq;
#pragma unroll
            for (int ai = 0; ai < 2; ++ai)
#pragma unroll
                for (int m = 0; m < 4; ++m) { const int row = row0 + ai * HALF + m * 16; const float r = rstd_row(ss, row, 1.0f / 1024.0f) * qs; const float fpos = (float)(row & 8191);
                    u32x4 w1, w2; float o1[8], o2[8];
#pragma unroll
                    for (int n = 0; n < 2; ++n)
#pragma unroll
                        for (int e = 0; e < 4; ++e) { float s, c; sincos_big(fpos * invf[4 * n + e], s, c); const float t1 = acc[ai][0][m][n][e] * r, t2 = acc[ai][1][m][n][e] * r;
                            o1[4 * n + e] = t1 * c - t2 * s; o2[4 * n + e] = t2 * c + t1 * s; }
#pragma unroll
                    for (int j = 0; j < 4; ++j) { w1[j] = pkbf(o1[2 * j], o1[2 * j + 1]); w2[j] = pkbf(o2[2 * j], o2[2 * j + 1]); }
                    bf16_t* rowp = O + (size_t)row * 3072 + col0; *(u32x4*)rowp = w1; *(u32x4*)(rowp + 32) = w2; }
        } else {
            const int col0 = u.pn * BM + wc * 32 + 8 * fq;
#pragma unroll
            for (int ai = 0; ai < 2; ++ai)
#pragma unroll
                for (int m = 0; m < 4; ++m) { const int row = row0 + ai * HALF + m * 16; const float r = rstd_row(ss, row, 1.0f / 1024.0f) * qs; bf16_t* rowp = O + (size_t)row * 3072 + col0;
#pragma unroll
                    for (int bj = 0; bj < 2; ++bj) { const f32x4 v0 = acc[ai][bj][m][0] * r, v1 = acc[ai][bj][m][1] * r; u32x4 w; w.x = pkbf(v0[0], v0[1]); w.y = pkbf(v0[2], v0[3]); w.z = pkbf(v1[0], v1[1]); w.w = pkbf(v1[2], v1[3]);
                        *(u32x4*)(rowp + bj * HALF) = w; } }
        }
    }
};
}

namespace att {
#define ATT_LAS __attribute__((address_space(3)))
typedef unsigned short bf16_t;
typedef short bf16x8 __attribute__((ext_vector_type(8)));
typedef short s16x4 __attribute__((ext_vector_type(4)));
typedef float f32x16 __attribute__((ext_vector_type(16)));
typedef unsigned u32x4 __attribute__((ext_vector_type(4)));
typedef unsigned u32x2 __attribute__((ext_vector_type(2)));
constexpr int SEQ = 8192, LDQ = 3072;
constexpr float SB_EXIT = -30.0f;
__device__ __forceinline__ float swap_other(float v, int h2) { auto rr = __builtin_amdgcn_permlane32_swap(__float_as_uint(v), __float_as_uint(v), false, false); return __uint_as_float(h2 ? rr[0] : rr[1]); }
__device__ __forceinline__ s16x4 vtr(const ATT_LAS char* p) { return __builtin_bit_cast(s16x4, __builtin_amdgcn_ds_read_tr16_b64_v4i16((ATT_LAS s16x4*)p)); }

template <bool SBK> __device__ __forceinline__ void item(const bf16_t* __restrict__ QKV, int b, int h, int dil, int c, int i0, ATT_LAS char* vl, bf16_t* O, float* LSE) {
    const int lane = threadIdx.x & 63, r = lane & 31, h2 = lane >> 5;
    const int qc = (SBK ? 0 : 1536) + h * 64, kc = qc + 512, vc = qc + 1024;
    const size_t rowb = (size_t)b * SEQ + c;
    bf16x8 qf[4];
    { const bf16_t* qp = QKV + (rowb + (size_t)(i0 + r) * dil) * LDQ + qc + 8 * h2;
#pragma unroll
      for (int s = 0; s < 4; ++s) qf[s] = *(const bf16x8*)(qp + 16 * s); }
    const int kbhi = i0 >> 5, kblo = SBK ? 0 : (kbhi - 4 > 0 ? kbhi - 4 : 0);
    f32x16 o0, o1;
#pragma unroll
    for (int i = 0; i < 16; ++i) { o0[i] = 0.f; o1[i] = 0.f; }
    float R = 0.f;
    float mrun = -1e30f, lrun = 0.f;
    bf16x8 kf[4]; u32x4 vr[4];
    auto loadkv = [&](int kb, bf16x8 (&kq)[4], u32x4 (&vq)[4]) {
        const bf16_t* kp = QKV + (rowb + (size_t)(32 * kb + r) * dil) * LDQ + kc + 8 * h2;
#pragma unroll
        for (int s = 0; s < 4; ++s) kq[s] = *(const bf16x8*)(kp + 16 * s);
#pragma unroll
        for (int i = 0; i < 4; ++i) { const int id = lane + 64 * i, key = id >> 3, ch = id & 7; vq[i] = *(const u32x4*)(QKV + (rowb + (size_t)(32 * kb + key) * dil) * LDQ + vc + 8 * ch); }
    };
    loadkv(kbhi, kf, vr);
    int buf = 0;
    const int tro = (4 * h2 + ((lane & 15) >> 2)) * 64 + ((lane >> 4) & 1) * 32 + (lane & 3) * 8;
    for (int kb = kbhi; kb >= kblo; --kb) {
        ATT_LAS char* vb = vl + buf * 4096;
#pragma unroll
        for (int i = 0; i < 4; ++i) { const int id = lane + 64 * i, key = id >> 3, ch = id & 7; *(ATT_LAS u32x4*)(vb + (ch >> 2) * 2048 + key * 64 + (ch & 3) * 16) = vr[i]; }
        bf16x8 kc4[4];
#pragma unroll
        for (int s = 0; s < 4; ++s) kc4[s] = kf[s];
        if (kb > kblo) loadkv(kb - 1, kf, vr);
        f32x16 st;
#pragma unroll
        for (int i = 0; i < 16; ++i) st[i] = 0.f;
#pragma unroll
        for (int s = 0; s < 4; ++s) st = __builtin_amdgcn_mfma_f32_32x32x16_bf16(kc4[s], qf[s], st, 0, 0, 0);
        const int dbase = (i0 - 32 * kb) + r - 4 * h2;
        float p[16];
        if (SBK) {
            float ls[16];
#pragma unroll
            for (int i = 0; i < 16; ++i) { const int dist = dbase - ((i & 3) + 8 * (i >> 2)); const float z = st[i];
                const float e = __builtin_amdgcn_exp2f(-__builtin_fabsf(z)); const float sp = __builtin_fmaxf(z, 0.f) + __builtin_amdgcn_logf(1.0f + e);
                ls[i] = dist >= 1 ? -sp : 0.f; }
            float rs[4], ot[4];
#pragma unroll
            for (int g = 0; g < 4; ++g) { ls[4 * g + 2] += ls[4 * g + 3]; ls[4 * g + 1] += ls[4 * g + 2]; ls[4 * g] += ls[4 * g + 1]; rs[g] = ls[4 * g]; }
#pragma unroll
            for (int g = 0; g < 4; ++g) ot[g] = swap_other(rs[g], h2);
            float after = R;
#pragma unroll
            for (int g = 3; g >= 0; --g) { const float off = after + (h2 == 0 ? ot[g] : 0.f);
#pragma unroll
                for (int e = 0; e < 4; ++e) { const int i = 4 * g + e; const int dist = dbase - ((i & 3) + 8 * (i >> 2)); p[i] = dist >= 1 ? __builtin_amdgcn_exp2f(st[i] + ls[i] + off) : 0.f; }
                after += rs[g] + ot[g]; }
            R = after;
        } else {
            float mx = -1e30f;
#pragma unroll
            for (int i = 0; i < 16; ++i) { const int dist = dbase - ((i & 3) + 8 * (i >> 2)); const bool ok = (unsigned)dist <= 128u; st[i] = ok ? st[i] : -1e30f; mx = __builtin_fmaxf(mx, st[i]); }
            mx = __builtin_fmaxf(mx, swap_other(mx, h2));
            const float mnew = __builtin_fmaxf(mrun, mx); const float alpha = __builtin_amdgcn_exp2f(mrun - mnew); mrun = mnew;
            float sum = 0.f;
#pragma unroll
            for (int i = 0; i < 16; ++i) { p[i] = __builtin_amdgcn_exp2f(st[i] - mnew); sum += p[i]; }
            lrun = lrun * alpha + sum;
#pragma unroll
            for (int i = 0; i < 16; ++i) { o0[i] *= alpha; o1[i] *= alpha; }
        }
        bf16x8 pb[2];
#pragma unroll
        for (int s = 0; s < 2; ++s) { u32x4 w; w.x = pg8::pkbf(p[8 * s], p[8 * s + 1]); w.y = pg8::pkbf(p[8 * s + 2], p[8 * s + 3]); w.z = pg8::pkbf(p[8 * s + 4], p[8 * s + 5]); w.w = pg8::pkbf(p[8 * s + 6], p[8 * s + 7]); pb[s] = __builtin_bit_cast(bf16x8, w); }
        asm volatile("s_waitcnt lgkmcnt(0)" ::: "memory");
#pragma unroll
        for (int s = 0; s < 2; ++s) {
            const s16x4 a0 = vtr(vb + tro + (16 * s) * 64), a1 = vtr(vb + tro + (16 * s + 8) * 64);
            const s16x4 b0 = vtr(vb + 2048 + tro + (16 * s) * 64), b1 = vtr(vb + 2048 + tro + (16 * s + 8) * 64);
            const bf16x8 va = __builtin_shufflevector(a0, a1, 0, 1, 2, 3, 4, 5, 6, 7), vbb = __builtin_shufflevector(b0, b1, 0, 1, 2, 3, 4, 5, 6, 7);
            o0 = __builtin_amdgcn_mfma_f32_32x32x16_bf16(va, pb[s], o0, 0, 0, 0);
            o1 = __builtin_amdgcn_mfma_f32_32x32x16_bf16(vbb, pb[s], o1, 0, 0, 0);
        }
        buf ^= 1;
        if (SBK) { if (__all(R < SB_EXIT)) break; }
    }
    float sc = 1.f;
    if (!SBK) { const float lt = lrun + swap_other(lrun, h2); sc = __builtin_amdgcn_rcpf(lt); if (h2 == 0) LSE[((size_t)rowb + (size_t)(i0 + r) * dil) * 8 + h] = mrun + __builtin_amdgcn_logf(lt); }
    bf16_t* op = O + (rowb + (size_t)(i0 + r) * dil) * 512 + h * 64 + 4 * h2;
#pragma unroll
    for (int g = 0; g < 4; ++g) { u32x2 w0, w1; w0.x = pg8::pkbf(o0[4 * g] * sc, o0[4 * g + 1] * sc); w0.y = pg8::pkbf(o0[4 * g + 2] * sc, o0[4 * g + 3] * sc);
        w1.x = pg8::pkbf(o1[4 * g] * sc, o1[4 * g + 1] * sc); w1.y = pg8::pkbf(o1[4 * g + 2] * sc, o1[4 * g + 3] * sc);
        *(u32x2*)(op + 8 * g) = w0; *(u32x2*)(op + 32 + 8 * g) = w1; }
}
}

constexpr int NWAVES = 8;
constexpr int BATCH = 2, SEQ = 8192, DM = 1024, DFF = 2816, DIN = 3072, M = BATCH * SEQ;
constexpr size_t MiB = 1u << 20;
constexpr size_t WS_SS = 0;
constexpr size_t WS_WGU1 = 1 * MiB, WS_WD1 = 12 * MiB, WS_WIN = 18 * MiB, WS_WOUT = 24 * MiB, WS_WGU2 = 26 * MiB, WS_WD2 = 37 * MiB;
constexpr size_t WS_XA = 43 * MiB, WS_XB = 75 * MiB;
constexpr size_t WS_H = 107 * MiB;
constexpr size_t WS_ODL = 203 * MiB;
constexpr size_t WS_OSB = WS_XB, WS_LSE = WS_XB + 16 * MiB;
constexpr size_t WS_END = 251 * MiB;
static_assert(WS_WD2 + (size_t)DM * DFF * 2 <= WS_XA && WS_H + (size_t)M * DIN * 2 <= WS_ODL && WS_ODL + (size_t)3 * M * 512 * 2 <= WS_END, "d_ws map");
constexpr int RING_BYTES = 131072, LDS_BYTES = 147456;

#define GAS __attribute__((address_space(1)))
#define LAS __attribute__((address_space(3)))
typedef unsigned short bf16;
typedef unsigned v4u __attribute__((ext_vector_type(4)));
typedef float f32x4 __attribute__((ext_vector_type(4)));
#define LDS_WAIT() asm volatile("s_waitcnt lgkmcnt(0)" ::: "memory")
using pg8::pkbf;

__device__ __forceinline__ float wave_sum(float v) {
#pragma unroll
    for (int o = 1; o < 64; o <<= 1) v += __shfl_xor(v, o);
    return v;
}
__device__ __forceinline__ void p0_item(const float* W, int ldw, int col0, int k0, const float* gain, bf16* WT, int K, int drow0, LAS float* scr, int lane) {
#pragma unroll 8
    for (int i = 0; i < 32; ++i) { const int kk = 2 * i + (lane >> 5); float v = W[(size_t)(k0 + kk) * ldw + col0 + (lane & 31)]; if (gain) v *= gain[k0 + kk]; scr[kk * 33 + (lane & 31)] = v; }
    LDS_WAIT(); asm volatile("" ::: "memory");
    const int c = lane & 7;
#pragma unroll
    for (int j = 0; j < 4; ++j) { const int n = (lane >> 3) + 8 * j; const LAS float* s = scr + (8 * c) * 33 + n;
        v4u o; o.x = pkbf(s[0 * 33], s[1 * 33]); o.y = pkbf(s[2 * 33], s[3 * 33]); o.z = pkbf(s[4 * 33], s[5 * 33]); o.w = pkbf(s[6 * 33], s[7 * 33]);
        *(v4u*)(WT + (size_t)(drow0 + n) * K + k0 + 8 * c) = o; }
    LDS_WAIT(); asm volatile("" ::: "memory");
}
__device__ __forceinline__ void p0_mat(int it, int kind, const float* s0, const float* s1, const float* gain, bf16* dst, int K, int Nd, int ldw, LAS float* scr, int lane) {
    const int nblk = Nd / 32, kb = it / nblk, nb = it % nblk; int col0 = 32 * nb; const float* src = s0;
    if (kind == 1) { const int pn = nb >> 3, half = (nb >> 2) & 1, o32 = nb & 3; src = half ? s1 : s0; col0 = 128 * pn + 32 * o32; }
    else if (kind == 2) { const int n0 = 32 * nb; if (n0 >= 1536 && n0 < 2560) { const int tl = (n0 - 1536) & 255, tb = n0 - tl, half = tl >> 7, hd = (tl & 127) >> 5; col0 = tb + 64 * hd + 32 * half; } }
    p0_item(src, ldw, col0, 64 * kb, gain, dst, K, 32 * nb, scr, lane);
}

struct Args { const float* in[15]; float* out; unsigned char* ws; int ph_lo, ph_hi; };

__global__ void __launch_bounds__(NWAVES * 64, 2) fwd_mega(Args a) {
    extern __shared__ __attribute__((aligned(16))) unsigned char lds_raw[];
    LAS unsigned char* lds = (LAS unsigned char*)lds_raw;
    const int tid = threadIdx.x, lane = tid & 63, wave = __builtin_amdgcn_readfirstlane(tid >> 6);
    const int G = gridDim.x, bx = blockIdx.x, vcu = (G % 8 == 0) ? (bx % 8) * (G / 8) + bx / 8 : bx;
    const int gw = vcu * NWAVES + wave, NGW = G * NWAVES;
    unsigned char* ws = a.ws;
    const float* x = a.in[0];
    float* ss1 = (float*)(ws + WS_SS); float* ss2 = ss1 + M; float* ss3 = ss2 + M; float* ss4 = ss3 + M;
    bf16* Wgu1 = (bf16*)(ws + WS_WGU1); bf16* Wd1 = (bf16*)(ws + WS_WD1); bf16* Win = (bf16*)(ws + WS_WIN); bf16* Wout = (bf16*)(ws + WS_WOUT); bf16* Wgu2 = (bf16*)(ws + WS_WGU2); bf16* Wd2 = (bf16*)(ws + WS_WD2);
    bf16* XA = (bf16*)(ws + WS_XA); bf16* XB = (bf16*)(ws + WS_XB); bf16* HB = (bf16*)(ws + WS_H); bf16* QKV = HB;
    bf16* ODL = (bf16*)(ws + WS_ODL); bf16* OSB = (bf16*)(ws + WS_OSB); float* LSE = (float*)(ws + WS_LSE);
    float* out = a.out;
    const int lo = a.ph_lo, hi = a.ph_hi;
    cg::grid_group grid = cg::this_grid();
#define IN(k) (lo <= (k) && (k) < hi)
#define SEAM(k) do { if (IN(k) && IN((k) + 1)) grid.sync(); } while (0)

    if (IN(0)) {
        LAS float* scr = (LAS float*)(lds + wave * 16384);
        constexpr int I_GU = (DM / 64) * (2 * DFF / 32), I_D = (DFF / 64) * (DM / 32), I_IN = (DM / 64) * (DIN / 32), I_OUT = (DM / 64) * (DM / 32);
        constexpr int NITEMS = 2 * I_GU + 2 * I_D + I_IN + I_OUT;
        for (int it = gw; it < NITEMS; it += NGW) {
            int r = it;
            if (r < I_GU) { p0_mat(r, 1, a.in[2], a.in[3], a.in[1], Wgu1, DM, 2 * DFF, DFF, scr, lane); continue; } r -= I_GU;
            if (r < I_D) { p0_mat(r, 0, a.in[4], nullptr, nullptr, Wd1, DFF, DM, DM, scr, lane); continue; } r -= I_D;
            if (r < I_IN) { p0_mat(r, 2, a.in[6], nullptr, a.in[5], Win, DM, DIN, DIN, scr, lane); continue; } r -= I_IN;
            if (r < I_OUT) { p0_mat(r, 0, a.in[9], nullptr, nullptr, Wout, DM, DM, DM, scr, lane); continue; } r -= I_OUT;
            if (r < I_GU) { p0_mat(r, 1, a.in[11], a.in[12], a.in[10], Wgu2, DM, 2 * DFF, DFF, scr, lane); continue; } r -= I_GU;
            p0_mat(r, 0, a.in[13], nullptr, nullptr, Wd2, DFF, DM, DM, scr, lane);
        }
        for (int m = gw; m < M; m += NGW) {
            const f32x4* xr = (const f32x4*)(x + (size_t)m * DM) + lane; f32x4 v[4]; float s = 0.f;
#pragma unroll
            for (int j = 0; j < 4; ++j) { v[j] = xr[64 * j]; s += (v[j].x * v[j].x + v[j].y * v[j].y) + (v[j].z * v[j].z + v[j].w * v[j].w); }
            s = wave_sum(s);
            unsigned long long* o8 = (unsigned long long*)(XA + (size_t)m * DM) + lane;
#pragma unroll
            for (int j = 0; j < 4; ++j) o8[64 * j] = (unsigned long long)pkbf(v[j].x, v[j].y) | ((unsigned long long)pkbf(v[j].z, v[j].w) << 32);
            if (lane == 0) { ss1[m] = s; ss2[m] = 0.f; ss3[m] = 0.f; ss4[m] = 0.f; }
        }
    }
    SEAM(0);
    if (IN(1)) { pg8::Gemm g{XA, Wgu1, M, 2 * DFF, DM}; pg8::StaticOrder S; S.init(M, 2 * DFF, G, bx); pg8::EpiSwiGLU E{HB, ss1, DFF};
        pg8::gemm_phase<pg8::EpiSwiGLU, pg8::StaticOrder, true, true>(lds, g, S, E); }
    SEAM(1);
    if (IN(2)) { pg8::Gemm g{HB, Wd1, M, DM, DFF}; pg8::StaticOrder S; S.init(M, DM, G, bx); pg8::EpiResid<true> E{x, out, XB, ss2, 0.5f};
        pg8::gemm_phase<pg8::EpiResid<true>, pg8::StaticOrder, true, true>(lds, g, S, E); }
    SEAM(2);
    if (IN(3)) { pg8::Gemm g{XB, Win, M, DIN, DM}; pg8::StaticOrder S; S.init(M, DIN, G, bx); pg8::EpiQKV E{QKV, ss2};
        pg8::gemm_phase<pg8::EpiQKV, pg8::StaticOrder, true, true>(lds, g, S, E); }
    SEAM(3);
    if (IN(4)) {
        LAS char* vl = (LAS char*)(lds + wave * 8192);
        for (int it = gw; it < 16384; it += NGW) {
            const int p = it >> 12, rem = it & 4095, bh = rem >> 8, bl = rem & 255, b = bh >> 3, h = bh & 7;
            if (p == 0) att::item<true>(QKV, b, h, 1, 0, 32 * bl, vl, OSB, nullptr);
            else { const int sh = (p == 1) ? 0 : (p == 2 ? 2 : 4), dil = 1 << sh, bpc = 256 >> sh, c = bl / bpc, blk = bl % bpc;
                att::item<false>(QKV, b, h, dil, c, 32 * blk, vl, ODL + (size_t)(p - 1) * M * 512, LSE + (size_t)(p - 1) * M * 8); }
        }
    }
    SEAM(4);
    if (IN(5)) {
        const float* gsb = a.in[7]; const float* gdl = a.in[8];
        for (int m = gw; m < M; m += NGW) {
            typedef short s16x8 __attribute__((ext_vector_type(8)));
            float v[8], w[8];
            { const s16x8 raw = *(const s16x8*)(OSB + (size_t)m * 512 + 8 * lane);
#pragma unroll
              for (int j = 0; j < 8; ++j) v[j] = __uint_as_float((unsigned)(unsigned short)raw[j] << 16); }
            { const int hh = lane >> 3; float l0 = LSE[(size_t)m * 8 + hh], l1 = LSE[((size_t)M + m) * 8 + hh], l2 = LSE[((size_t)2 * M + m) * 8 + hh];
              const float mx = __builtin_fmaxf(l0, __builtin_fmaxf(l1, l2)); l0 = __builtin_amdgcn_exp2f(l0 - mx); l1 = __builtin_amdgcn_exp2f(l1 - mx); l2 = __builtin_amdgcn_exp2f(l2 - mx);
              const float inv = __builtin_amdgcn_rcpf(l0 + l1 + l2); l0 *= inv; l1 *= inv; l2 *= inv;
              const s16x8 r0 = *(const s16x8*)(ODL + (size_t)m * 512 + 8 * lane), r1 = *(const s16x8*)(ODL + ((size_t)M + m) * 512 + 8 * lane), r2 = *(const s16x8*)(ODL + ((size_t)2 * M + m) * 512 + 8 * lane);
#pragma unroll
              for (int j = 0; j < 8; ++j) w[j] = l0 * __uint_as_float((unsigned)(unsigned short)r0[j] << 16) + l1 * __uint_as_float((unsigned)(unsigned short)r1[j] << 16) + l2 * __uint_as_float((unsigned)(unsigned short)r2[j] << 16); }
            float s1 = 0.f, s2 = 0.f;
#pragma unroll
            for (int j = 0; j < 8; ++j) { s1 += v[j] * v[j]; s2 += w[j] * w[j]; }
            s1 = wave_sum(s1); s2 = wave_sum(s2);
            const float r1 = __builtin_amdgcn_rsqf(s1 * (1.0f / 512.0f) + pg8::RMS_EPS), r2 = __builtin_amdgcn_rsqf(s2 * (1.0f / 512.0f) + pg8::RMS_EPS);
            const f32x4 ga = *(const f32x4*)(gsb + 8 * lane), gb = *(const f32x4*)(gsb + 8 * lane + 4), gc = *(const f32x4*)(gdl + 8 * lane), gd = *(const f32x4*)(gdl + 8 * lane + 4);
            v4u o1, o2;
            o1.x = pkbf(v[0] * r1 * ga.x, v[1] * r1 * ga.y); o1.y = pkbf(v[2] * r1 * ga.z, v[3] * r1 * ga.w); o1.z = pkbf(v[4] * r1 * gb.x, v[5] * r1 * gb.y); o1.w = pkbf(v[6] * r1 * gb.z, v[7] * r1 * gb.w);
            o2.x = pkbf(w[0] * r2 * gc.x, w[1] * r2 * gc.y); o2.y = pkbf(w[2] * r2 * gc.z, w[3] * r2 * gc.w); o2.z = pkbf(w[4] * r2 * gd.x, w[5] * r2 * gd.y); o2.w = pkbf(w[6] * r2 * gd.z, w[7] * r2 * gd.w);
            *(v4u*)(XA + (size_t)m * DM + 8 * lane) = o1; *(v4u*)(XA + (size_t)m * DM + 512 + 8 * lane) = o2;
        }
    }
    SEAM(5);
    if (IN(6)) { pg8::Gemm g{XA, Wout, M, DM, DM}; pg8::StaticOrder S; S.init(M, DM, G, bx); pg8::EpiResid<true> E{out, out, XB, ss3, 1.0f};
        pg8::gemm_phase<pg8::EpiResid<true>, pg8::StaticOrder, true, true>(lds, g, S, E); }
    SEAM(6);
    if (IN(7)) { pg8::Gemm g{XB, Wgu2, M, 2 * DFF, DM}; pg8::StaticOrder S; S.init(M, 2 * DFF, G, bx); pg8::EpiSwiGLU E{HB, ss3, DFF};
        pg8::gemm_phase<pg8::EpiSwiGLU, pg8::StaticOrder, true, true>(lds, g, S, E); }
    SEAM(7);
    if (IN(8)) { pg8::Gemm g{HB, Wd2, M, DM, DFF}; pg8::StaticOrder S; S.init(M, DM, G, bx); pg8::EpiResid<false> E{out, out, nullptr, ss4, 0.5f};
        pg8::gemm_phase<pg8::EpiResid<false>, pg8::StaticOrder, true, true>(lds, g, S, E); }
    SEAM(8);
    if (IN(9)) {
        const float* gf = a.in[14];
        for (int m = gw; m < M; m += NGW) { const float r = __builtin_amdgcn_rsqf(ss4[m] * (1.0f / 1024.0f) + pg8::RMS_EPS); f32x4* xr = (f32x4*)(out + (size_t)m * DM) + lane; const f32x4* gr = (const f32x4*)gf + lane;
#pragma unroll
            for (int j = 0; j < 4; ++j) { const f32x4 v = xr[64 * j], g4 = gr[64 * j]; xr[64 * j] = v * r * g4; } }
    }
#undef IN
#undef SEAM
}

#ifndef N_LAUNCHES
#define N_LAUNCHES 1
#endif
extern "C" void kernel_launch(void* const* d_in, const int* in_sizes, int n_in, void* d_out, int out_size, void* d_ws, size_t ws_size, hipStream_t stream) {
    static int grid = 0;
    if (grid == 0) {
        if (n_in != 15 || in_sizes[0] != M * DM || out_size != M * DM || ws_size < WS_END) { fprintf(stderr, "kernel_launch: unexpected shapes / workspace (n_in %d, ws %zu)\n", n_in, ws_size); grid = -1; return; }
        int dev = 0, cus = 0, per_cu = 0;
        hipGetDevice(&dev); hipDeviceGetAttribute(&cus, hipDeviceAttributeMultiprocessorCount, dev);
        if (hipFuncSetAttribute((const void*)fwd_mega, hipFuncAttributeMaxDynamicSharedMemorySize, LDS_BYTES) != hipSuccess) { fprintf(stderr, "kernel_launch: hipFuncSetAttribute failed\n"); grid = -1; return; }
        if (hipOccupancyMaxActiveBlocksPerMultiprocessor(&per_cu, (const void*)fwd_mega, NWAVES * 64, LDS_BYTES) != hipSuccess || per_cu < 1) per_cu = 1;
        (void)hipGetLastError();
        grid = cus * per_cu;
    }
    if (grid < 0) return;
    Args a{};
    for (int i = 0; i < 15; ++i) a.in[i] = (const float*)d_in[i];
    a.out = (float*)d_out; a.ws = (unsigned char*)d_ws;
    if (N_LAUNCHES == 1) {
        a.ph_lo = 0; a.ph_hi = 10; void* args[] = {&a};
        hipError_t e = hipLaunchCooperativeKernel((const void*)fwd_mega, dim3(grid), dim3(NWAVES * 64), args, LDS_BYTES, stream);
        if (e != hipSuccess) fprintf(stderr, "cooperative launch failed: %s (grid %d)\n", hipGetErrorString(e), grid);
    } else {
        for (int p = 0; p < 10; ++p) { a.ph_lo = p; a.ph_hi = p + 1; hipLaunchKernelGGL(fwd_mega, dim3(grid), dim3(NWAVES * 64), LDS_BYTES, stream, a); }
    }
}
```

```cpp
#include <hip/hip_runtime.h>
#include <hip/hip_cooperative_groups.h>
#include <cstdio>
#include <cstdint>
#include <cmath>
namespace cg = cooperative_groups;
namespace pg8 {
#define PG8_LAS __attribute__((address_space(3)))
typedef unsigned short bf16_t;
typedef short bf16x8 __attribute__((ext_vector_type(8)));
typedef float f32x4 __attribute__((ext_vector_type(4)));
typedef unsigned u32x4 __attribute__((ext_vector_type(4)));
constexpr int BM = 256, BK = 64, HALF = 128, HTB = HALF * BK * 2  , STAGE_BYTES = 8 * HTB, NXCD = 8, WGM = 8;

__host__ __device__ __forceinline__ int lds_byte(int r, int c) { const int st = (r >> 4) * 2 + (c >> 5), rr = r & 15, cc = c & 31, ob = rr * 64 + cc * 2; return st * 1024 + (ob ^ (((ob >> 9) & 1) << 5)); }
__host__ __device__ __forceinline__ void stage_rc(int b, int& R, int& C) { const int st = b / 1024, sb = b % 1024, swz = sb ^ (((sb >> 9) & 1) << 5); R = (st >> 1) * 16 + swz / 64; C = (st & 1) * 32 + (swz % 64) / 2; }
__host__ __device__ __forceinline__ int perm32(int rho) { const int n = rho >> 4, i = rho & 15; return 8 * (i >> 2) + 4 * n + (i & 3); }

struct Unit { int pm, pn; };
struct Gemm { const bf16_t* A; const bf16_t* Bt; int M, N, K; };

struct StaticOrder {
    int nM, nN, nwg, G, c;
    __host__ __device__ void init(int M, int N, int G_, int c_) { nM = M / BM; nN = N / BM; nwg = nM * nN; G = G_; c = c_; }
    __host__ __device__ bool next(int i, Unit& u) const {
        const long L = (long)i * G + c; if (L >= nwg) return false;
        int wgid = (int)L; { const int q = nwg / NXCD, r = nwg % NXCD, xcd = wgid % NXCD, off = wgid / NXCD; wgid = (xcd < r ? xcd * (q + 1) : r * (q + 1) + (xcd - r) * q) + off; }
        const int nig = WGM * nN, gid = wgid / nig, fm = gid * WGM, gsz = (nM - fm) < WGM ? (nM - fm) : WGM;
        u.pm = fm + ((wgid % nig) % gsz); u.pn = (wgid % nig) / gsz; return true;
    }
    __device__ __forceinline__ void a_ready(const Unit&) const {}
    __device__ __forceinline__ void done(const Unit&) const {}
};

__device__ __forceinline__ unsigned cvt_pk_bf16(float lo, float hi) { unsigned r; asm volatile("v_cvt_pk_bf16_f32 %0, %1, %2" : "=v"(r) : "v"(lo), "v"(hi)); return r; }
typedef float f32x2 __attribute__((ext_vector_type(2)));
template <class Epi, class Sched, bool ALIGN_EPI = false, bool SP2 = false>
__device__ __forceinline__ void gemm_phase(PG8_LAS unsigned char* lds, const Gemm g, const Sched& S, const Epi& E) {
    const int tid = threadIdx.x, wid = __builtin_amdgcn_readfirstlane(tid >> 6), lane = tid & 63, wr = wid >> 2, wc = wid & 3, fr = lane & 15, fq = lane >> 4;
    const int K = g.K, nt = K / BK;
    unsigned voffA[2], voffB[2];
#pragma unroll
    for (int i = 0; i < 2; ++i) { int R, C; stage_rc(tid * 16 + i * 8192, R, C); const int Rb = Epi::PERM ? ((R & ~31) + perm32(R & 31)) : R;
        voffA[i] = (unsigned)(R * K + C) * 2u; voffB[i] = (unsigned)(Rb * K + C) * 2u; }
    const size_t kstep = (size_t)(BK * 2);
    const size_t hstep = (size_t)HALF * K * 2;
    const size_t tstep = 2 * hstep;
    const unsigned ldsw = (unsigned)wid * 1024u;
    const int aoff = lds_byte(wr * 64 + fr, fq * 8), boff = lds_byte(wc * 32 + fr, fq * 8);
#define PG8_SA(b, h) (((b) * 2 + (h)) * HTB)
#define PG8_SB(b, h) ((4 + (b) * 2 + (h)) * HTB)
#define PG8_STAGE(bufoff, gbase, voff) do { _Pragma("unroll") for (int _i = 0; _i < 2; ++_i) \
        __builtin_amdgcn_global_load_lds((const unsigned*)((const char*)(gbase) + (voff)[_i]), (PG8_LAS unsigned*)(lds + (bufoff) + ldsw + _i * 8192), 16, 0, 0); } while (0)
#define PG8_LDA(dst, b, h) do { _Pragma("unroll") for (int m = 0; m < 4; ++m) _Pragma("unroll") for (int k = 0; k < 2; ++k) dst[m][k] = *(const PG8_LAS bf16x8*)(lds + PG8_SA(b, h) + aoff + m * 2048 + k * 1024); } while (0)
#define PG8_LDB(dst, b, h) do { _Pragma("unroll") for (int n = 0; n < 2; ++n) _Pragma("unroll") for (int k = 0; k < 2; ++k) dst[n][k] = *(const PG8_LAS bf16x8*)(lds + PG8_SB(b, h) + boff + n * 2048 + k * 1024); } while (0)
#define PG8_MMA(ai, bj, At, Bt) do { __builtin_amdgcn_s_setprio(1); _Pragma("unroll") for (int m = 0; m < 4; ++m) _Pragma("unroll") for (int n = 0; n < 2; ++n) _Pragma("unroll") for (int k = 0; k < 2; ++k) \
        acc[ai][bj][m][n] = __builtin_amdgcn_mfma_f32_16x16x32_bf16(Bt[n][k], At[m][k], acc[ai][bj][m][n], 0, 0, 0); __builtin_amdgcn_s_setprio(0); } while (0)
#define PG8_WAIT_V(n) asm volatile("s_waitcnt vmcnt(" #n ")" ::: "memory")
#define PG8_WAIT_L(n) asm volatile("s_waitcnt lgkmcnt(" #n ")" ::: "memory")
#define PG8_BAR __builtin_amdgcn_s_barrier()
#define PG8_SCHED __builtin_amdgcn_sched_barrier(0)
    Unit cur, nxt; int ui = 0;
    if (!S.next(0, cur)) return;
    f32x4 acc[2][2][4][2];
#pragma unroll
    for (int a = 0; a < 2; ++a)
#pragma unroll
        for (int b = 0; b < 2; ++b)
#pragma unroll
            for (int m = 0; m < 4; ++m)
#pragma unroll
                for (int n = 0; n < 2; ++n) acc[a][b][m][n] = (f32x4){0.f, 0.f, 0.f, 0.f};
    bf16x8 At[4][2], B0[2][2], B1[2][2];
    const char* cA = (const char*)g.A + (size_t)cur.pm * tstep; const char* cB = (const char*)g.Bt + (size_t)cur.pn * tstep;
    S.a_ready(cur);
    if constexpr (SP2) {
        PG8_STAGE(PG8_SB(0, 0), cB, voffB); PG8_STAGE(PG8_SB(0, 1), cB + hstep, voffB); PG8_STAGE(PG8_SA(0, 0), cA, voffA); PG8_STAGE(PG8_SA(0, 1), cA + hstep, voffA);
        if (wr == 1) PG8_BAR;
        PG8_WAIT_V(2); PG8_BAR;
        PG8_STAGE(PG8_SB(1, 0), cB + kstep, voffB); PG8_STAGE(PG8_SA(1, 0), cA + kstep, voffA); PG8_STAGE(PG8_SB(1, 1), cB + hstep + kstep, voffB);
        PG8_WAIT_V(6); PG8_BAR;
    } else {
        PG8_STAGE(PG8_SB(0, 0), cB, voffB); PG8_STAGE(PG8_SA(0, 0), cA, voffA); PG8_STAGE(PG8_SB(0, 1), cB + hstep, voffB); PG8_STAGE(PG8_SA(0, 1), cA + hstep, voffA);
        if (wr == 1) PG8_BAR;
        PG8_WAIT_V(4); PG8_BAR;
        PG8_STAGE(PG8_SB(1, 0), cB + kstep, voffB); PG8_STAGE(PG8_SA(1, 0), cA + kstep, voffA); PG8_STAGE(PG8_SB(1, 1), cB + hstep + kstep, voffB);
        PG8_WAIT_V(6); PG8_BAR;
    }
    for (;;) {
        const bool has_next = S.next(ui + 1, nxt);
        const char* nA = has_next ? (const char*)g.A + (size_t)nxt.pm * tstep : cA; const char* nB = has_next ? (const char*)g.Bt + (size_t)nxt.pn * tstep : cB;
        for (int t = 0; t < nt; t += 2) {
            const bool last = (t == nt - 2);
            const char* a1 = cA + (size_t)(t + 1) * kstep;
            const char* a2 = last ? nA : cA + (size_t)(t + 2) * kstep; const char* b2 = last ? nB : cB + (size_t)(t + 2) * kstep;
            const char* a3 = a2 + kstep; const char* b3 = b2 + kstep;
            if (last && has_next) S.a_ready(nxt);
            if constexpr (SP2) {
            PG8_LDB(B0, 0, 0); PG8_LDB(B1, 0, 1); PG8_SCHED; PG8_LDA(At, 0, 0); PG8_STAGE(PG8_SA(1, 1), a1 + hstep, voffA);
            PG8_WAIT_V(8); PG8_WAIT_L(0); PG8_BAR; PG8_MMA(0, 0, At, B0); PG8_MMA(0, 1, At, B1); PG8_BAR; PG8_SCHED;
            PG8_LDA(At, 0, 1); PG8_STAGE(PG8_SB(0, 0), b2, voffB); PG8_STAGE(PG8_SB(0, 1), b2 + hstep, voffB); PG8_STAGE(PG8_SA(0, 0), a2, voffA);
            PG8_WAIT_V(8); PG8_WAIT_L(0); PG8_BAR; PG8_MMA(1, 0, At, B0); PG8_MMA(1, 1, At, B1); PG8_BAR; PG8_SCHED;
            PG8_LDB(B0, 1, 0); PG8_LDB(B1, 1, 1); PG8_SCHED; PG8_LDA(At, 1, 0); PG8_STAGE(PG8_SA(0, 1), a2 + hstep, voffA);
            PG8_WAIT_V(8); PG8_WAIT_L(0); PG8_BAR; PG8_MMA(0, 0, At, B0); PG8_MMA(0, 1, At, B1); PG8_BAR; PG8_SCHED;
            PG8_LDA(At, 1, 1); PG8_STAGE(PG8_SB(1, 0), b3, voffB); PG8_STAGE(PG8_SB(1, 1), b3 + hstep, voffB); PG8_STAGE(PG8_SA(1, 0), a3, voffA);
            PG8_WAIT_V(8); PG8_WAIT_L(0); PG8_BAR; PG8_MMA(1, 0, At, B0); PG8_MMA(1, 1, At, B1); PG8_BAR; PG8_SCHED;
            } else {
            PG8_LDB(B0, 0, 0); PG8_SCHED; PG8_LDA(At, 0, 0); PG8_STAGE(PG8_SA(1, 1), a1 + hstep, voffA);
            PG8_WAIT_L(8); PG8_BAR; PG8_WAIT_L(0); PG8_MMA(0, 0, At, B0); PG8_BAR; PG8_SCHED;
            PG8_LDB(B1, 0, 1); PG8_STAGE(PG8_SB(0, 0), b2, voffB);
            PG8_BAR; PG8_WAIT_L(0); PG8_MMA(0, 1, At, B1); PG8_BAR;
            PG8_LDA(At, 0, 1); PG8_STAGE(PG8_SA(0, 0), a2, voffA);
            PG8_BAR; PG8_WAIT_L(0); PG8_MMA(1, 0, At, B0); PG8_BAR; PG8_SCHED;
            PG8_STAGE(PG8_SB(0, 1), b2 + hstep, voffB);
            PG8_WAIT_V(6); PG8_BAR; PG8_MMA(1, 1, At, B1); PG8_BAR;
            PG8_LDB(B0, 1, 0); PG8_SCHED; PG8_LDA(At, 1, 0); PG8_STAGE(PG8_SA(0, 1), a2 + hstep, voffA);
            PG8_WAIT_L(8); PG8_BAR; PG8_WAIT_L(0); PG8_MMA(0, 0, At, B0); PG8_BAR; PG8_SCHED;
            PG8_LDB(B1, 1, 1); PG8_STAGE(PG8_SB(1, 0), b3, voffB);
            PG8_BAR; PG8_WAIT_L(0); PG8_MMA(0, 1, At, B1); PG8_BAR;
            PG8_LDA(At, 1, 1); PG8_STAGE(PG8_SA(1, 0), a3, voffA);
            PG8_BAR; PG8_WAIT_L(0); PG8_MMA(1, 0, At, B0); PG8_BAR; PG8_SCHED;
            PG8_STAGE(PG8_SB(1, 1), b3 + hstep, voffB);
            PG8_WAIT_V(6); PG8_BAR; PG8_MMA(1, 1, At, B1); PG8_BAR;
            }
        }
        if constexpr (ALIGN_EPI) { if (wr == 0) PG8_BAR; }
        if constexpr (!Epi::AFTER_DRAIN) { E(acc, cur, wr, wc, fr, fq); S.done(cur); }
        if (!has_next) break;
#pragma unroll
        for (int a = 0; a < 2; ++a)
#pragma unroll
            for (int b = 0; b < 2; ++b)
#pragma unroll
                for (int m = 0; m < 4; ++m)
#pragma unroll
                    for (int n = 0; n < 2; ++n) acc[a][b][m][n] = (f32x4){0.f, 0.f, 0.f, 0.f};
        cur = nxt; cA = nA; cB = nB; ++ui;
        if constexpr (ALIGN_EPI) { if (wr == 1) PG8_BAR; }
    }
    PG8_WAIT_V(0);
    if constexpr (!ALIGN_EPI) { if (wr == 0) PG8_BAR; }
    PG8_BAR;
    if constexpr (Epi::AFTER_DRAIN) { E.fused(acc, cur, wr, wc, fr, fq, lds, wid, lane); S.done(cur); }
#undef PG8_SA
#undef PG8_SB
#undef PG8_STAGE
#undef PG8_LDA
#undef PG8_LDB
#undef PG8_MMA
#undef PG8_WAIT_V
#undef PG8_WAIT_L
#undef PG8_BAR
#undef PG8_SCHED
}
}

namespace pg8 {
constexpr float RMS_EPS = 1e-6f;
constexpr float C2 = 0.125f * 1.4426950408889634f;
typedef __bf16 bf16x2_t __attribute__((ext_vector_type(2)));
__device__ __forceinline__ unsigned pkbf(float lo, float hi) { f32x2 v = {lo, hi}; bf16x2_t b = __builtin_convertvector(v, bf16x2_t); return __builtin_bit_cast(unsigned, b); }
__device__ __forceinline__ float rstd_row(const float* ss, int row, float inv_n) { return __builtin_amdgcn_rsqf(ss[row] * inv_n + RMS_EPS); }

struct EpiSwiGLU {
    static constexpr bool PERM = true, AFTER_DRAIN = false;
    bf16_t* H; const float* ss; int ldh;
    __device__ __forceinline__ void operator()(const f32x4 (&acc)[2][2][4][2], const Unit& u, int wr, int wc, int fr, int fq) const {
        const int row0 = u.pm * BM + wr * 64 + fr, col0 = u.pn * HALF + wc * 32 + 8 * fq;
#pragma unroll
        for (int ai = 0; ai < 2; ++ai)
#pragma unroll
            for (int m = 0; m < 4; ++m) { const int row = row0 + ai * HALF + m * 16; const float r = rstd_row(ss, row, 1.0f / 1024.0f);
                u32x4 w;
#pragma unroll
                for (int n = 0; n < 2; ++n) { const f32x4 g = acc[ai][0][m][n] * r, up = acc[ai][1][m][n] * r; float hv[4];
#pragma unroll
                    for (int e = 0; e < 4; ++e) { const float sg = g[e] * __builtin_amdgcn_rcpf(1.0f + __builtin_amdgcn_exp2f(-1.4426950408889634f * g[e])); hv[e] = sg * up[e]; }
                    w[2 * n] = pkbf(hv[0], hv[1]); w[2 * n + 1] = pkbf(hv[2], hv[3]); }
                *(u32x4*)(H + (size_t)row * ldh + col0) = w; }
    }
};
template <bool WXB> struct EpiResid {
    static constexpr bool PERM = false, AFTER_DRAIN = false;
    const float* xin; float* xout; bf16_t* xb; float* ss; float alpha;
    __device__ __forceinline__ void operator()(const f32x4 (&acc)[2][2][4][2], const Unit& u, int wr, int wc, int fr, int fq) const {
        typedef unsigned u32x2v __attribute__((ext_vector_type(2)));
        const int row0 = u.pm * BM + wr * 64 + fr, col0 = u.pn * BM + wc * 32 + 4 * fq;
#pragma unroll
        for (int ai = 0; ai < 2; ++ai)
#pragma unroll
            for (int m = 0; m < 4; ++m) { const int row = row0 + ai * HALF + m * 16; const size_t off = (size_t)row * 1024 + col0; float q = 0.f;
#pragma unroll
                for (int bj = 0; bj < 2; ++bj)
#pragma unroll
                    for (int n = 0; n < 2; ++n) { const f32x4 b = *(const f32x4*)(xin + off + bj * HALF + n * 16); const f32x4 v = b + acc[ai][bj][m][n] * alpha;
                        *(f32x4*)(xout + off + bj * HALF + n * 16) = v; q += (v[0] * v[0] + v[1] * v[1]) + (v[2] * v[2] + v[3] * v[3]);
                        if (WXB) { u32x2v w; w.x = pkbf(v[0], v[1]); w.y = pkbf(v[2], v[3]); *(u32x2v*)(xb + off + bj * HALF + n * 16) = w; } }
                q += __shfl_xor(q, 16); q += __shfl_xor(q, 32);
                if (fq == 0) atomicAdd(ss + row, q); }
    }
};
__device__ __forceinline__ void sincos_big(float ang, float& s, float& c) {
    const float CH = 0.15915493667125702f, CL = 6.4206382432985265e-09f;
    const float hi = ang * CH; const float lo = __builtin_fmaf(ang, CH, -hi) + ang * CL;
    const float x = __builtin_amdgcn_fractf(hi) + lo;
    s = __builtin_amdgcn_sinf(x); c = __builtin_amdgcn_cosf(x);
}
struct EpiQKV {
    static constexpr bool PERM = true, AFTER_DRAIN = false;
    bf16_t* O; const float* ss;
    __device__ __forceinline__ void operator()(const f32x4 (&acc)[2][2][4][2], const Unit& u, int wr, int wc, int fr, int fq) const {
        const int type = u.pn >> 1; const float qs = (type == 0 || type == 3) ? C2 : 1.0f;
        const int row0 = u.pm * BM + wr * 64 + fr;
        if (type == 3 || type == 4) {
            float invf[8];
#pragma unroll
            for (int j = 0; j < 8; ++j) invf[j] = exp2f(-(float)(8 * fq + j) * 0.4152410118609203f);
            const int col0 = u.pn * BM + wc * 64 + 8 * fq;
#pragma unroll
            for (int ai = 0; ai < 2; ++ai)
#pragma unroll
                for (int m = 0; m < 4; ++m) { const int row = row0 + ai * HALF + m * 16; const float r = rstd_row(ss, row, 1.0f / 1024.0f) * qs; const float fpos = (float)(row & 8191);
                    u32x4 w1, w2; float o1[8], o2[8];
#pragma unroll
                    for (int n = 0; n < 2; ++n)
#pragma unroll
                        for (int e = 0; e < 4; ++e) { float s, c; sincos_big(fpos * invf[4 * n + e], s, c); const float t1 = acc[ai][0][m][n][e] * r, t2 = acc[ai][1][m][n][e] * r;
                            o1[4 * n + e] = t1 * c - t2 * s; o2[4 * n + e] = t2 * c + t1 * s; }
#pragma unroll
                    for (int j = 0; j < 4; ++j) { w1[j] = pkbf(o1[2 * j], o1[2 * j + 1]); w2[j] = pkbf(o2[2 * j], o2[2 * j + 1]); }
                    bf16_t* rowp = O + (size_t)row * 3072 + col0; *(u32x4*)rowp = w1; *(u32x4*)(rowp + 32) = w2; }
        } else {
            const int col0 = u.pn * BM + wc * 32 + 8 * fq;
#pragma unroll
            for (int ai = 0; ai < 2; ++ai)
#pragma unroll
                for (int m = 0; m < 4; ++m) { const int row = row0 + ai * HALF + m * 16; const float r = rstd_row(ss, row, 1.0f / 1024.0f) * qs; bf16_t* rowp = O + (size_t)row * 3072 + col0;
#pragma unroll
                    for (int bj = 0; bj < 2; ++bj) { const f32x4 v0 = acc[ai][bj][m][0] * r, v1 = acc[ai][bj][m][1] * r; u32x4 w; w.x = pkbf(v0[0], v0[1]); w.y = pkbf(v0[2], v0[3]); w.z = pkbf(v1[0], v1[1]); w.w = pkbf(v1[2], v1[3]);
                        *(u32x4*)(rowp + bj * HALF) = w; } }
        }
    }
};
}

namespace att {
#define ATT_LAS __attribute__((address_space(3)))
typedef unsigned short bf16_t;
typedef short bf16x8 __attribute__((ext_vector_type(8)));
typedef short s16x4 __attribute__((ext_vector_type(4)));
typedef float f32x16 __attribute__((ext_vector_type(16)));
typedef unsigned u32x4 __attribute__((ext_vector_type(4)));
typedef unsigned u32x2 __attribute__((ext_vector_type(2)));
constexpr int SEQ = 8192, LDQ = 3072;
constexpr float SB_EXIT = -30.0f;
__device__ __forceinline__ float swap_other(float v, int h2) { auto rr = __builtin_amdgcn_permlane32_swap(__float_as_uint(v), __float_as_uint(v), false, false); return __uint_as_float(h2 ? rr[0] : rr[1]); }
__device__ __forceinline__ s16x4 vtr(const ATT_LAS char* p) { return __builtin_bit_cast(s16x4, __builtin_amdgcn_ds_read_tr16_b64_v4i16((ATT_LAS s16x4*)p)); }

template <bool SBK> __device__ __forceinline__ void item(const bf16_t* __restrict__ QKV, int b, int h, int dil, int c, int i0, ATT_LAS char* vl, bf16_t* O, float* LSE) {
    const int lane = threadIdx.x & 63, r = lane & 31, h2 = lane >> 5;
    const int qc = (SBK ? 0 : 1536) + h * 64, kc = qc + 512, vc = qc + 1024;
    const size_t rowb = (size_t)b * SEQ + c;
    bf16x8 qf[4];
    { const bf16_t* qp = QKV + (rowb + (size_t)(i0 + r) * dil) * LDQ + qc + 8 * h2;
#pragma unroll
      for (int s = 0; s < 4; ++s) qf[s] = *(const bf16x8*)(qp + 16 * s); }
    const int kbhi = i0 >> 5, kblo = SBK ? 0 : (kbhi - 4 > 0 ? kbhi - 4 : 0);
    f32x16 o0, o1;
#pragma unroll
    for (int i = 0; i < 16; ++i) { o0[i] = 0.f; o1[i] = 0.f; }
    float R = 0.f;
    float mrun = -1e30f, lrun = 0.f;
    bf16x8 kf[4]; u32x4 vr[4];
    auto loadkv = [&](int kb, bf16x8 (&kq)[4], u32x4 (&vq)[4]) {
        const bf16_t* kp = QKV + (rowb + (size_t)(32 * kb + r) * dil) * LDQ + kc + 8 * h2;
#pragma unroll
        for (int s = 0; s < 4; ++s) kq[s] = *(const bf16x8*)(kp + 16 * s);
#pragma unroll
        for (int i = 0; i < 4; ++i) { const int id = lane + 64 * i, key = id >> 3, ch = id & 7; vq[i] = *(const u32x4*)(QKV + (rowb + (size_t)(32 * kb + key) * dil) * LDQ + vc + 8 * ch); }
    };
    loadkv(kbhi, kf, vr);
    int buf = 0;
    const int tro = (4 * h2 + ((lane & 15) >> 2)) * 64 + ((lane >> 4) & 1) * 32 + (lane & 3) * 8;
    for (int kb = kbhi; kb >= kblo; --kb) {
        ATT_LAS char* vb = vl + buf * 4096;
#pragma unroll
        for (int i = 0; i < 4; ++i) { const int id = lane + 64 * i, key = id >> 3, ch = id & 7; *(ATT_LAS u32x4*)(vb + (ch >> 2) * 2048 + key * 64 + (ch & 3) * 16) = vr[i]; }
        bf16x8 kc4[4];
#pragma unroll
        for (int s = 0; s < 4; ++s) kc4[s] = kf[s];
        if (kb > kblo) loadkv(kb - 1, kf, vr);
        f32x16 st;
#pragma unroll
        for (int i = 0; i < 16; ++i) st[i] = 0.f;
#pragma unroll
        for (int s = 0; s < 4; ++s) st = __builtin_amdgcn_mfma_f32_32x32x16_bf16(kc4[s], qf[s], st, 0, 0, 0);
        const int dbase = (i0 - 32 * kb) + r - 4 * h2;
        float p[16];
        if (SBK) {
            float ls[16];
#pragma unroll
            for (int i = 0; i < 16; ++i) { const int dist = dbase - ((i & 3) + 8 * (i >> 2)); const float z = st[i];
                const float e = __builtin_amdgcn_exp2f(-__builtin_fabsf(z)); const float sp = __builtin_fmaxf(z, 0.f) + __builtin_amdgcn_logf(1.0f + e);
                ls[i] = dist >= 1 ? -sp : 0.f; }
            float rs[4], ot[4];
#pragma unroll
            for (int g = 0; g < 4; ++g) { ls[4 * g + 2] += ls[4 * g + 3]; ls[4 * g + 1] += ls[4 * g + 2]; ls[4 * g] += ls[4 * g + 1]; rs[g] = ls[4 * g]; }
#pragma unroll
            for (int g = 0; g < 4; ++g) ot[g] = swap_other(rs[g], h2);
            float after = R;
#pragma unroll
            for (int g = 3; g >= 0; --g) { const float off = after + (h2 == 0 ? ot[g] : 0.f);
#pragma unroll
                for (int e = 0; e < 4; ++e) { const int i = 4 * g + e; const int dist = dbase - ((i & 3) + 8 * (i >> 2)); p[i] = dist >= 1 ? __builtin_amdgcn_exp2f(st[i] + ls[i] + off) : 0.f; }
                after += rs[g] + ot[g]; }
            R = after;
        } else {
            float mx = -1e30f;
#pragma unroll
            for (int i = 0; i < 16; ++i) { const int dist = dbase - ((i & 3) + 8 * (i >> 2)); const bool ok = (unsigned)dist <= 128u; st[i] = ok ? st[i] : -1e30f; mx = __builtin_fmaxf(mx, st[i]); }
            mx = __builtin_fmaxf(mx, swap_other(mx, h2));
            const float mnew = __builtin_fmaxf(mrun, mx); const float alpha = __builtin_amdgcn_exp2f(mrun - mnew); mrun = mnew;
            float sum = 0.f;
#pragma unroll
            for (int i = 0; i < 16; ++i) { p[i] = __builtin_amdgcn_exp2f(st[i] - mnew); sum += p[i]; }
            lrun = lrun * alpha + sum;
#pragma unroll
            for (int i = 0; i < 16; ++i) { o0[i] *= alpha; o1[i] *= alpha; }
        }
        bf16x8 pb[2];
#pragma unroll
        for (int s = 0; s < 2; ++s) { u32x4 w; w.x = pg8::pkbf(p[8 * s], p[8 * s + 1]); w.y = pg8::pkbf(p[8 * s + 2], p[8 * s + 3]); w.z = pg8::pkbf(p[8 * s + 4], p[8 * s + 5]); w.w = pg8::pkbf(p[8 * s + 6], p[8 * s + 7]); pb[s] = __builtin_bit_cast(bf16x8, w); }
        asm volatile("s_waitcnt lgkmcnt(0)" ::: "memory");
#pragma unroll
        for (int s = 0; s < 2; ++s) {
            const s16x4 a0 = vtr(vb + tro + (16 * s) * 64), a1 = vtr(vb + tro + (16 * s + 8) * 64);
            const s16x4 b0 = vtr(vb + 2048 + tro + (16 * s) * 64), b1 = vtr(vb + 2048 + tro + (16 * s + 8) * 64);
            const bf16x8 va = __builtin_shufflevector(a0, a1, 0, 1, 2, 3, 4, 5, 6, 7), vbb = __builtin_shufflevector(b0, b1, 0, 1, 2, 3, 4, 5, 6, 7);
            o0 = __builtin_amdgcn_mfma_f32_32x32x16_bf16(va, pb[s], o0, 0, 0, 0);
            o1 = __builtin_amdgcn_mfma_f32_32x32x16_bf16(vbb, pb[s], o1, 0, 0, 0);
        }
        buf ^= 1;
        if (SBK) { if (__all(R < SB_EXIT)) break; }
    }
    float sc = 1.f;
    if (!SBK) { const float lt = lrun + swap_other(lrun, h2); sc = __builtin_amdgcn_rcpf(lt); if (h2 == 0) LSE[((size_t)rowb + (size_t)(i0 + r) * dil) * 8 + h] = mrun + __builtin_amdgcn_logf(lt); }
    bf16_t* op = O + (rowb + (size_t)(i0 + r) * dil) * 512 + h * 64 + 4 * h2;
#pragma unroll
    for (int g = 0; g < 4; ++g) { u32x2 w0, w1; w0.x = pg8::pkbf(o0[4 * g] * sc, o0[4 * g + 1] * sc); w0.y = pg8::pkbf(o0[4 * g + 2] * sc, o0[4 * g + 3] * sc);
        w1.x = pg8::pkbf(o1[4 * g] * sc, o1[4 * g + 1] * sc); w1.y = pg8::pkbf(o1[4 * g + 2] * sc, o1[4 * g + 3] * sc);
        *(u32x2*)(op + 8 * g) = w0; *(u32x2*)(op + 32 + 8 * g) = w1; }
}
}

constexpr int NWAVES = 8;
constexpr int BATCH = 2, SEQ = 8192, DM = 1024, DFF = 2816, DIN = 3072, M = BATCH * SEQ;
constexpr size_t MiB = 1u << 20;
constexpr size_t WS_SS = 0;
constexpr size_t WS_BAR = 512 * 1024, BAR_BYTES = 16384;
constexpr size_t WS_WGU1 = 1 * MiB, WS_WD1 = 12 * MiB, WS_WIN = 18 * MiB, WS_WOUT = 24 * MiB, WS_WGU2 = 26 * MiB, WS_WD2 = 37 * MiB;
constexpr size_t WS_XA = 43 * MiB, WS_XB = 75 * MiB;
constexpr size_t WS_H = 107 * MiB;
constexpr size_t WS_ODL = 203 * MiB;
constexpr size_t WS_OSB = WS_XB, WS_LSE = WS_XB + 16 * MiB;
constexpr size_t WS_END = 251 * MiB;
static_assert(WS_WD2 + (size_t)DM * DFF * 2 <= WS_XA && WS_H + (size_t)M * DIN * 2 <= WS_ODL && WS_ODL + (size_t)3 * M * 512 * 2 <= WS_END, "d_ws map");
constexpr int RING_BYTES = 131072, LDS_BYTES = 147456;

#define GAS __attribute__((address_space(1)))
#define LAS __attribute__((address_space(3)))
typedef unsigned short bf16;
typedef unsigned v4u __attribute__((ext_vector_type(4)));
typedef float f32x4 __attribute__((ext_vector_type(4)));
#define LDS_WAIT() asm volatile("s_waitcnt lgkmcnt(0)" ::: "memory")
using pg8::pkbf;
#define RLX_AGENT __ATOMIC_RELAXED, __HIP_MEMORY_SCOPE_AGENT
#define XB_TMO      128
#define XB_XCNT(j)  (256  + 64 * (j))
#define XB_XSUB(j)  (1280 + 64 * (j))
#define XB_XGEN(j)  (2304 + 64 * (j))
#define XB_TOP      3328
#define XB_TOPGEN   3392
#define XCD_BAR_WORDS 3456
#define XB_SPIN_CAP (1u << 18)

__device__ __forceinline__ unsigned xb_ld(unsigned* p)              { return __hip_atomic_load(p, __ATOMIC_RELAXED, __HIP_MEMORY_SCOPE_AGENT); }
__device__ __forceinline__ unsigned xb_add(unsigned* p, unsigned v) { return __hip_atomic_fetch_add(p, v, __ATOMIC_RELAXED, __HIP_MEMORY_SCOPE_AGENT); }
__device__ __forceinline__ unsigned xb_xcc_id() { return (unsigned)__builtin_amdgcn_s_getreg((3 << 11) | 20) & 0xFu; }
#define XB_SPIN(cond, bar) do { unsigned _sp = 0; while (cond) { __builtin_amdgcn_s_sleep(1); \
    if ((++_sp & 255u) == 0u) { if (xb_ld(&(bar)[XB_TMO])) break; if (_sp > XB_SPIN_CAP) { atomicAdd(&(bar)[XB_TMO], 1u); break; } } } } while (0)

struct XcdBarrier {
    unsigned* bar; unsigned x;
    volatile LAS unsigned* st;
};

__device__ __forceinline__ XcdBarrier xcd_barrier_post(unsigned* bar, volatile LAS unsigned* st) {
    XcdBarrier b; b.bar = bar; b.x = xb_xcc_id(); b.st = st;
    if (threadIdx.x == 0) (void)xb_add(&bar[XB_XCNT(b.x)], 1u);
    return b;
}
__device__ __forceinline__ void xcd_barrier_complete(unsigned* bar, unsigned x, unsigned& nloc, unsigned& nx) {
    const unsigned G = gridDim.x * gridDim.y * gridDim.z;
    unsigned sum, cnt, mine, sp = 0u;
    for (;;) {
        sum = 0u; cnt = 0u; mine = 0u;
#pragma unroll
        for (unsigned j = 0; j < 16; ++j) { const unsigned c = xb_ld(&bar[XB_XCNT(j)]); sum += c; cnt += (c > 0u) ? 1u : 0u; mine = (j == x) ? c : mine; }
        if (sum == G) break;
        __builtin_amdgcn_s_sleep(1);
        if ((++sp & 255u) == 0u) { if (xb_ld(&bar[XB_TMO])) break; if (sp > XB_SPIN_CAP) { atomicAdd(&bar[XB_TMO], 1u); break; } }
    }
    nloc = mine > 0u ? mine : 1u; nx = cnt > 0u ? cnt : 1u;
}

__device__ __forceinline__ void xcd_barrier(const XcdBarrier& b) {
    asm volatile("s_waitcnt vmcnt(0)" ::: "memory");
    __syncthreads();
    if (threadIdx.x == 0) {
        unsigned* bar = b.bar;
        __builtin_amdgcn_s_waitcnt(0);
        unsigned nloc = b.st[0], nx = b.st[1];
        if (nloc == 0u) { xcd_barrier_complete(bar, b.x, nloc, nx); b.st[0] = nloc; b.st[1] = nx; }
        const unsigned old = xb_add(&bar[XB_XSUB(b.x)], 1u);
        const unsigned gen = old / nloc;
        if (old + 1u == (gen + 1u) * nloc) {
            __builtin_amdgcn_fence(__ATOMIC_RELEASE, "agent");
            asm volatile("s_waitcnt vmcnt(0)" ::: "memory");
            const unsigned og = xb_add(&bar[XB_TOP], 1u);
            const unsigned tg = og / nx;
            if (og + 1u == (tg + 1u) * nx) xb_add(&bar[XB_TOPGEN], 1u);
            else XB_SPIN(xb_ld(&bar[XB_TOPGEN]) == tg, bar);
            __builtin_amdgcn_fence(__ATOMIC_ACQUIRE, "agent");
            xb_add(&bar[XB_XGEN(b.x)], 1u);
            asm volatile("s_waitcnt vmcnt(0)" ::: "memory");
        } else {
            XB_SPIN(xb_ld(&bar[XB_XGEN(b.x)]) == gen, bar);
            __builtin_amdgcn_fence(__ATOMIC_ACQUIRE, "agent");
            asm volatile("s_waitcnt vmcnt(0)" ::: "memory");
        }
    }
    __syncthreads();
}


__device__ __forceinline__ float wave_sum(float v) {
#pragma unroll
    for (int o = 1; o < 64; o <<= 1) v += __shfl_xor(v, o);
    return v;
}
__device__ __forceinline__ void p0_item(const float* W, int ldw, int col0, int k0, const float* gain, bf16* WT, int K, int drow0, LAS float* scr, int lane) {
#pragma unroll 8
    for (int i = 0; i < 32; ++i) { const int kk = 2 * i + (lane >> 5); float v = W[(size_t)(k0 + kk) * ldw + col0 + (lane & 31)]; if (gain) v *= gain[k0 + kk]; scr[kk * 33 + (lane & 31)] = v; }
    LDS_WAIT(); asm volatile("" ::: "memory");
    const int c = lane & 7;
#pragma unroll
    for (int j = 0; j < 4; ++j) { const int n = (lane >> 3) + 8 * j; const LAS float* s = scr + (8 * c) * 33 + n;
        v4u o; o.x = pkbf(s[0 * 33], s[1 * 33]); o.y = pkbf(s[2 * 33], s[3 * 33]); o.z = pkbf(s[4 * 33], s[5 * 33]); o.w = pkbf(s[6 * 33], s[7 * 33]);
        *(v4u*)(WT + (size_t)(drow0 + n) * K + k0 + 8 * c) = o; }
    LDS_WAIT(); asm volatile("" ::: "memory");
}
__device__ __forceinline__ void p0_mat(int it, int kind, const float* s0, const float* s1, const float* gain, bf16* dst, int K, int Nd, int ldw, LAS float* scr, int lane) {
    const int nblk = Nd / 32, kb = it / nblk, nb = it % nblk; int col0 = 32 * nb; const float* src = s0;
    if (kind == 1) { const int pn = nb >> 3, half = (nb >> 2) & 1, o32 = nb & 3; src = half ? s1 : s0; col0 = 128 * pn + 32 * o32; }
    else if (kind == 2) { const int n0 = 32 * nb; if (n0 >= 1536 && n0 < 2560) { const int tl = (n0 - 1536) & 255, tb = n0 - tl, half = tl >> 7, hd = (tl & 127) >> 5; col0 = tb + 64 * hd + 32 * half; } }
    p0_item(src, ldw, col0, 64 * kb, gain, dst, K, 32 * nb, scr, lane);
}

struct Args { const float* in[15]; float* out; unsigned char* ws; int ph_lo, ph_hi; };

__global__ void __launch_bounds__(NWAVES * 64, 2) fwd_mega(Args a) {
    extern __shared__ __attribute__((aligned(16))) unsigned char lds_raw[];
    LAS unsigned char* lds = (LAS unsigned char*)lds_raw;
    const int tid = threadIdx.x, lane = tid & 63, wave = __builtin_amdgcn_readfirstlane(tid >> 6);
    const int G = gridDim.x, bx = blockIdx.x, vcu = (G % 8 == 0) ? (bx % 8) * (G / 8) + bx / 8 : bx;
    const int gw = vcu * NWAVES + wave, NGW = G * NWAVES;
    unsigned char* ws = a.ws;
    const float* x = a.in[0];
    float* ss1 = (float*)(ws + WS_SS); float* ss2 = ss1 + M; float* ss3 = ss2 + M; float* ss4 = ss3 + M;
    bf16* Wgu1 = (bf16*)(ws + WS_WGU1); bf16* Wd1 = (bf16*)(ws + WS_WD1); bf16* Win = (bf16*)(ws + WS_WIN); bf16* Wout = (bf16*)(ws + WS_WOUT); bf16* Wgu2 = (bf16*)(ws + WS_WGU2); bf16* Wd2 = (bf16*)(ws + WS_WD2);
    bf16* XA = (bf16*)(ws + WS_XA); bf16* XB = (bf16*)(ws + WS_XB); bf16* HB = (bf16*)(ws + WS_H); bf16* QKV = HB;
    bf16* ODL = (bf16*)(ws + WS_ODL); bf16* OSB = (bf16*)(ws + WS_OSB); float* LSE = (float*)(ws + WS_LSE);
    float* out = a.out;
    const int lo = a.ph_lo, hi = a.ph_hi;
    cg::grid_group grid = cg::this_grid();
    volatile LAS unsigned* bst = (volatile LAS unsigned*)(lds + RING_BYTES + 64);
    if (tid == 0) { bst[0] = 0u; bst[1] = 0u; }
    __syncthreads();
    XcdBarrier bar = xcd_barrier_post((unsigned*)(ws + WS_BAR), bst);
#define IN(k) (lo <= (k) && (k) < hi)
#define SEAM(k) do { if (IN(k) && IN((k) + 1)) { if (lo < 0) grid.sync(); else xcd_barrier(bar); } } while (0)

    if (IN(0)) {
        LAS float* scr = (LAS float*)(lds + wave * 16384);
        constexpr int I_GU = (DM / 64) * (2 * DFF / 32), I_D = (DFF / 64) * (DM / 32), I_IN = (DM / 64) * (DIN / 32), I_OUT = (DM / 64) * (DM / 32);
        constexpr int NITEMS = 2 * I_GU + 2 * I_D + I_IN + I_OUT;
        for (int it = gw; it < NITEMS; it += NGW) {
            int r = it;
            if (r < I_GU) { p0_mat(r, 1, a.in[2], a.in[3], a.in[1], Wgu1, DM, 2 * DFF, DFF, scr, lane); continue; } r -= I_GU;
            if (r < I_D) { p0_mat(r, 0, a.in[4], nullptr, nullptr, Wd1, DFF, DM, DM, scr, lane); continue; } r -= I_D;
            if (r < I_IN) { p0_mat(r, 2, a.in[6], nullptr, a.in[5], Win, DM, DIN, DIN, scr, lane); continue; } r -= I_IN;
            if (r < I_OUT) { p0_mat(r, 0, a.in[9], nullptr, nullptr, Wout, DM, DM, DM, scr, lane); continue; } r -= I_OUT;
            if (r < I_GU) { p0_mat(r, 1, a.in[11], a.in[12], a.in[10], Wgu2, DM, 2 * DFF, DFF, scr, lane); continue; } r -= I_GU;
            p0_mat(r, 0, a.in[13], nullptr, nullptr, Wd2, DFF, DM, DM, scr, lane);
        }
        for (int m = gw; m < M; m += NGW) {
            const f32x4* xr = (const f32x4*)(x + (size_t)m * DM) + lane; f32x4 v[4]; float s = 0.f;
#pragma unroll
            for (int j = 0; j < 4; ++j) { v[j] = xr[64 * j]; s += (v[j].x * v[j].x + v[j].y * v[j].y) + (v[j].z * v[j].z + v[j].w * v[j].w); }
            s = wave_sum(s);
            unsigned long long* o8 = (unsigned long long*)(XA + (size_t)m * DM) + lane;
#pragma unroll
            for (int j = 0; j < 4; ++j) o8[64 * j] = (unsigned long long)pkbf(v[j].x, v[j].y) | ((unsigned long long)pkbf(v[j].z, v[j].w) << 32);
            if (lane == 0) { ss1[m] = s; ss2[m] = 0.f; ss3[m] = 0.f; ss4[m] = 0.f; }
        }
    }
    SEAM(0);
    if (IN(1)) { pg8::Gemm g{XA, Wgu1, M, 2 * DFF, DM}; pg8::StaticOrder S; S.init(M, 2 * DFF, G, bx); pg8::EpiSwiGLU E{HB, ss1, DFF};
        pg8::gemm_phase<pg8::EpiSwiGLU, pg8::StaticOrder, true, true>(lds, g, S, E); }
    SEAM(1);
    if (IN(2)) { pg8::Gemm g{HB, Wd1, M, DM, DFF}; pg8::StaticOrder S; S.init(M, DM, G, bx); pg8::EpiResid<true> E{x, out, XB, ss2, 0.5f};
        pg8::gemm_phase<pg8::EpiResid<true>, pg8::StaticOrder, true, true>(lds, g, S, E); }
    SEAM(2);
    if (IN(3)) { pg8::Gemm g{XB, Win, M, DIN, DM}; pg8::StaticOrder S; S.init(M, DIN, G, bx); pg8::EpiQKV E{QKV, ss2};
        pg8::gemm_phase<pg8::EpiQKV, pg8::StaticOrder, true, true>(lds, g, S, E); }
    SEAM(3);
    if (IN(4)) {
        LAS char* vl = (LAS char*)(lds + wave * 8192);
        for (int it = gw; it < 16384; it += NGW) {
            const int p = it >> 12, rem = it & 4095, bh = rem >> 8, bl = rem & 255, b = bh >> 3, h = bh & 7;
            if (p == 0) att::item<true>(QKV, b, h, 1, 0, 32 * bl, vl, OSB, nullptr);
            else { const int sh = (p == 1) ? 0 : (p == 2 ? 2 : 4), dil = 1 << sh, bpc = 256 >> sh, c = bl / bpc, blk = bl % bpc;
                att::item<false>(QKV, b, h, dil, c, 32 * blk, vl, ODL + (size_t)(p - 1) * M * 512, LSE + (size_t)(p - 1) * M * 8); }
        }
    }
    SEAM(4);
    if (IN(5)) {
        const float* gsb = a.in[7]; const float* gdl = a.in[8];
        for (int m = gw; m < M; m += NGW) {
            typedef short s16x8 __attribute__((ext_vector_type(8)));
            float v[8], w[8];
            { const s16x8 raw = *(const s16x8*)(OSB + (size_t)m * 512 + 8 * lane);
#pragma unroll
              for (int j = 0; j < 8; ++j) v[j] = __uint_as_float((unsigned)(unsigned short)raw[j] << 16); }
            { const int hh = lane >> 3; float l0 = LSE[(size_t)m * 8 + hh], l1 = LSE[((size_t)M + m) * 8 + hh], l2 = LSE[((size_t)2 * M + m) * 8 + hh];
              const float mx = __builtin_fmaxf(l0, __builtin_fmaxf(l1, l2)); l0 = __builtin_amdgcn_exp2f(l0 - mx); l1 = __builtin_amdgcn_exp2f(l1 - mx); l2 = __builtin_amdgcn_exp2f(l2 - mx);
              const float inv = __builtin_amdgcn_rcpf(l0 + l1 + l2); l0 *= inv; l1 *= inv; l2 *= inv;
              const s16x8 r0 = *(const s16x8*)(ODL + (size_t)m * 512 + 8 * lane), r1 = *(const s16x8*)(ODL + ((size_t)M + m) * 512 + 8 * lane), r2 = *(const s16x8*)(ODL + ((size_t)2 * M + m) * 512 + 8 * lane);
#pragma unroll
              for (int j = 0; j < 8; ++j) w[j] = l0 * __uint_as_float((unsigned)(unsigned short)r0[j] << 16) + l1 * __uint_as_float((unsigned)(unsigned short)r1[j] << 16) + l2 * __uint_as_float((unsigned)(unsigned short)r2[j] << 16); }
            float s1 = 0.f, s2 = 0.f;
#pragma unroll
            for (int j = 0; j < 8; ++j) { s1 += v[j] * v[j]; s2 += w[j] * w[j]; }
            s1 = wave_sum(s1); s2 = wave_sum(s2);
            const float r1 = __builtin_amdgcn_rsqf(s1 * (1.0f / 512.0f) + pg8::RMS_EPS), r2 = __builtin_amdgcn_rsqf(s2 * (1.0f / 512.0f) + pg8::RMS_EPS);
            const f32x4 ga = *(const f32x4*)(gsb + 8 * lane), gb = *(const f32x4*)(gsb + 8 * lane + 4), gc = *(const f32x4*)(gdl + 8 * lane), gd = *(const f32x4*)(gdl + 8 * lane + 4);
            v4u o1, o2;
            o1.x = pkbf(v[0] * r1 * ga.x, v[1] * r1 * ga.y); o1.y = pkbf(v[2] * r1 * ga.z, v[3] * r1 * ga.w); o1.z = pkbf(v[4] * r1 * gb.x, v[5] * r1 * gb.y); o1.w = pkbf(v[6] * r1 * gb.z, v[7] * r1 * gb.w);
            o2.x = pkbf(w[0] * r2 * gc.x, w[1] * r2 * gc.y); o2.y = pkbf(w[2] * r2 * gc.z, w[3] * r2 * gc.w); o2.z = pkbf(w[4] * r2 * gd.x, w[5] * r2 * gd.y); o2.w = pkbf(w[6] * r2 * gd.z, w[7] * r2 * gd.w);
            *(v4u*)(XA + (size_t)m * DM + 8 * lane) = o1; *(v4u*)(XA + (size_t)m * DM + 512 + 8 * lane) = o2;
        }
    }
    SEAM(5);
    if (IN(6)) { pg8::Gemm g{XA, Wout, M, DM, DM}; pg8::StaticOrder S; S.init(M, DM, G, bx); pg8::EpiResid<true> E{out, out, XB, ss3, 1.0f};
        pg8::gemm_phase<pg8::EpiResid<true>, pg8::StaticOrder, true, true>(lds, g, S, E); }
    SEAM(6);
    if (IN(7)) { pg8::Gemm g{XB, Wgu2, M, 2 * DFF, DM}; pg8::StaticOrder S; S.init(M, 2 * DFF, G, bx); pg8::EpiSwiGLU E{HB, ss3, DFF};
        pg8::gemm_phase<pg8::EpiSwiGLU, pg8::StaticOrder, true, true>(lds, g, S, E); }
    SEAM(7);
    if (IN(8)) { pg8::Gemm g{HB, Wd2, M, DM, DFF}; pg8::StaticOrder S; S.init(M, DM, G, bx); pg8::EpiResid<false> E{out, out, nullptr, ss4, 0.5f};
        pg8::gemm_phase<pg8::EpiResid<false>, pg8::StaticOrder, true, true>(lds, g, S, E); }
    SEAM(8);
    if (IN(9)) {
        const float* gf = a.in[14];
        for (int m = gw; m < M; m += NGW) { const float r = __builtin_amdgcn_rsqf(ss4[m] * (1.0f / 1024.0f) + pg8::RMS_EPS); f32x4* xr = (f32x4*)(out + (size_t)m * DM) + lane; const f32x4* gr = (const f32x4*)gf + lane;
#pragma unroll
            for (int j = 0; j < 4; ++j) { const f32x4 v = xr[64 * j], g4 = gr[64 * j]; xr[64 * j] = v * r * g4; } }
    }
#undef IN
#undef SEAM
}

#ifndef N_LAUNCHES
#define N_LAUNCHES 1
#endif
extern "C" void kernel_launch(void* const* d_in, const int* in_sizes, int n_in, void* d_out, int out_size, void* d_ws, size_t ws_size, hipStream_t stream) {
    static int grid = 0;
    if (grid == 0) {
        if (n_in != 15 || in_sizes[0] != M * DM || out_size != M * DM || ws_size < WS_END) { fprintf(stderr, "kernel_launch: unexpected shapes / workspace (n_in %d, ws %zu)\n", n_in, ws_size); grid = -1; return; }
        int dev = 0, cus = 0, per_cu = 0;
        hipGetDevice(&dev); hipDeviceGetAttribute(&cus, hipDeviceAttributeMultiprocessorCount, dev);
        if (hipFuncSetAttribute((const void*)fwd_mega, hipFuncAttributeMaxDynamicSharedMemorySize, LDS_BYTES) != hipSuccess) { fprintf(stderr, "kernel_launch: hipFuncSetAttribute failed\n"); grid = -1; return; }
        if (hipOccupancyMaxActiveBlocksPerMultiprocessor(&per_cu, (const void*)fwd_mega, NWAVES * 64, LDS_BYTES) != hipSuccess || per_cu < 1) per_cu = 1;
        (void)hipGetLastError();
        grid = cus * per_cu;
    }
    if (grid < 0) return;
    Args a{};
    for (int i = 0; i < 15; ++i) a.in[i] = (const float*)d_in[i];
    a.out = (float*)d_out; a.ws = (unsigned char*)d_ws;
    if (hipMemsetAsync((char*)d_ws + WS_BAR, 0, BAR_BYTES, stream) != hipSuccess) { fprintf(stderr, "kernel_launch: memset failed\n"); return; }
    if (N_LAUNCHES == 1) {
        a.ph_lo = 0; a.ph_hi = 10; void* args[] = {&a};
        hipError_t e = hipLaunchCooperativeKernel((const void*)fwd_mega, dim3(grid), dim3(NWAVES * 64), args, LDS_BYTES, stream);
        if (e != hipSuccess) fprintf(stderr, "cooperative launch failed: %s (grid %d)\n", hipGetErrorString(e), grid);
    } else {
        for (int p = 0; p < 10; ++p) { a.ph_lo = p; a.ph_hi = p + 1; hipLaunchKernelGGL(fwd_mega, dim3(grid), dim3(NWAVES * 64), LDS_BYTES, stream, a); }
    }
}
```

```cpp
#include <hip/hip_runtime.h>
#include <hip/hip_cooperative_groups.h>
#include <cstdio>
#include <cstdint>
#include <cmath>
namespace cg = cooperative_groups;
namespace pg8 {
#define PG8_LAS __attribute__((address_space(3)))
typedef unsigned short bf16_t;
typedef short bf16x8 __attribute__((ext_vector_type(8)));
typedef float f32x4 __attribute__((ext_vector_type(4)));
typedef unsigned u32x4 __attribute__((ext_vector_type(4)));
constexpr int BM = 256, BK = 64, HALF = 128, HTB = HALF * BK * 2  , STAGE_BYTES = 8 * HTB, NXCD = 8, WGM = 8;

__host__ __device__ __forceinline__ int lds_byte(int r, int c) { const int st = (r >> 4) * 2 + (c >> 5), rr = r & 15, cc = c & 31, ob = rr * 64 + cc * 2; return st * 1024 + (ob ^ (((ob >> 9) & 1) << 5)); }
__host__ __device__ __forceinline__ void stage_rc(int b, int& R, int& C) { const int st = b / 1024, sb = b % 1024, swz = sb ^ (((sb >> 9) & 1) << 5); R = (st >> 1) * 16 + swz / 64; C = (st & 1) * 32 + (swz % 64) / 2; }
__host__ __device__ __forceinline__ int perm32(int rho) { const int n = rho >> 4, i = rho & 15; return 8 * (i >> 2) + 4 * n + (i & 3); }

struct Unit { int pm, pn; };
struct Gemm { const bf16_t* A; const bf16_t* Bt; int M, N, K; };

struct StaticOrder {
    int nM, nN, nwg, G, c;
    __host__ __device__ void init(int M, int N, int G_, int c_) { nM = M / BM; nN = N / BM; nwg = nM * nN; G = G_; c = c_; }
    __host__ __device__ bool next(int i, Unit& u) const {
        const long L = (long)i * G + c; if (L >= nwg) return false;
        int wgid = (int)L; { const int q = nwg / NXCD, r = nwg % NXCD, xcd = wgid % NXCD, off = wgid / NXCD; wgid = (xcd < r ? xcd * (q + 1) : r * (q + 1) + (xcd - r) * q) + off; }
        const int nig = WGM * nN, gid = wgid / nig, fm = gid * WGM, gsz = (nM - fm) < WGM ? (nM - fm) : WGM;
        u.pm = fm + ((wgid % nig) % gsz); u.pn = (wgid % nig) / gsz; return true;
    }
    __device__ __forceinline__ void a_ready(const Unit&) const {}
    __device__ __forceinline__ void done(const Unit&) const {}
};

__device__ __forceinline__ unsigned cvt_pk_bf16(float lo, float hi) { unsigned r; asm volatile("v_cvt_pk_bf16_f32 %0, %1, %2" : "=v"(r) : "v"(lo), "v"(hi)); return r; }
typedef float f32x2 __attribute__((ext_vector_type(2)));
template <class Epi, class Sched, bool ALIGN_EPI = false, bool SP2 = false>
__device__ __forceinline__ void gemm_phase(PG8_LAS unsigned char* lds, const Gemm g, const Sched& S, const Epi& E) {
    const int tid = threadIdx.x, wid = __builtin_amdgcn_readfirstlane(tid >> 6), lane = tid & 63, wr = wid >> 2, wc = wid & 3, fr = lane & 15, fq = lane >> 4;
    const int K = g.K, nt = K / BK;
    unsigned voffA[2], voffB[2];
#pragma unroll
    for (int i = 0; i < 2; ++i) { int R, C; stage_rc(tid * 16 + i * 8192, R, C); const int Rb = Epi::PERM ? ((R & ~31) + perm32(R & 31)) : R;
        voffA[i] = (unsigned)(R * K + C) * 2u; voffB[i] = (unsigned)(Rb * K + C) * 2u; }
    const size_t kstep = (size_t)(BK * 2);
    const size_t hstep = (size_t)HALF * K * 2;
    const size_t tstep = 2 * hstep;
    const unsigned ldsw = (unsigned)wid * 1024u;
    const int aoff = lds_byte(wr * 64 + fr, fq * 8), boff = lds_byte(wc * 32 + fr, fq * 8);
#define PG8_SA(b, h) (((b) * 2 + (h)) * HTB)
#define PG8_SB(b, h) ((4 + (b) * 2 + (h)) * HTB)
#define PG8_STAGE(bufoff, gbase, voff) do { _Pragma("unroll") for (int _i = 0; _i < 2; ++_i) \
        __builtin_amdgcn_global_load_lds((const unsigned*)((const char*)(gbase) + (voff)[_i]), (PG8_LAS unsigned*)(lds + (bufoff) + ldsw + _i * 8192), 16, 0, 0); } while (0)
#define PG8_LDA(dst, b, h) do { _Pragma("unroll") for (int m = 0; m < 4; ++m) _Pragma("unroll") for (int k = 0; k < 2; ++k) dst[m][k] = *(const PG8_LAS bf16x8*)(lds + PG8_SA(b, h) + aoff + m * 2048 + k * 1024); } while (0)
#define PG8_LDB(dst, b, h) do { _Pragma("unroll") for (int n = 0; n < 2; ++n) _Pragma("unroll") for (int k = 0; k < 2; ++k) dst[n][k] = *(const PG8_LAS bf16x8*)(lds + PG8_SB(b, h) + boff + n * 2048 + k * 1024); } while (0)
#define PG8_MMA(ai, bj, At, Bt) do { __builtin_amdgcn_s_setprio(1); _Pragma("unroll") for (int m = 0; m < 4; ++m) _Pragma("unroll") for (int n = 0; n < 2; ++n) _Pragma("unroll") for (int k = 0; k < 2; ++k) \
        acc[ai][bj][m][n] = __builtin_amdgcn_mfma_f32_16x16x32_bf16(Bt[n][k], At[m][k], acc[ai][bj][m][n], 0, 0, 0); __builtin_amdgcn_s_setprio(0); } while (0)
#define PG8_WAIT_V(n) asm volatile("s_waitcnt vmcnt(" #n ")" ::: "memory")
#define PG8_WAIT_L(n) asm volatile("s_waitcnt lgkmcnt(" #n ")" ::: "memory")
#define PG8_BAR __builtin_amdgcn_s_barrier()
#define PG8_SCHED __builtin_amdgcn_sched_barrier(0)
    Unit cur, nxt; int ui = 0;
    if (!S.next(0, cur)) return;
    f32x4 acc[2][2][4][2];
#pragma unroll
    for (int a = 0; a < 2; ++a)
#pragma unroll
        for (int b = 0; b < 2; ++b)
#pragma unroll
            for (int m = 0; m < 4; ++m)
#pragma unroll
                for (int n = 0; n < 2; ++n) acc[a][b][m][n] = (f32x4){0.f, 0.f, 0.f, 0.f};
    bf16x8 At[4][2], B0[2][2], B1[2][2];
    const char* cA = (const char*)g.A + (size_t)cur.pm * tstep; const char* cB = (const char*)g.Bt + (size_t)cur.pn * tstep;
    S.a_ready(cur);
    if constexpr (SP2) {
        PG8_STAGE(PG8_SB(0, 0), cB, voffB); PG8_STAGE(PG8_SB(0, 1), cB + hstep, voffB); PG8_STAGE(PG8_SA(0, 0), cA, voffA); PG8_STAGE(PG8_SA(0, 1), cA + hstep, voffA);
        if (wr == 1) PG8_BAR;
        PG8_WAIT_V(2); PG8_BAR;
        PG8_STAGE(PG8_SB(1, 0), cB + kstep, voffB); PG8_STAGE(PG8_SA(1, 0), cA + kstep, voffA); PG8_STAGE(PG8_SB(1, 1), cB + hstep + kstep, voffB);
        PG8_WAIT_V(6); PG8_BAR;
    } else {
        PG8_STAGE(PG8_SB(0, 0), cB, voffB); PG8_STAGE(PG8_SA(0, 0), cA, voffA); PG8_STAGE(PG8_SB(0, 1), cB + hstep, voffB); PG8_STAGE(PG8_SA(0, 1), cA + hstep, voffA);
        if (wr == 1) PG8_BAR;
        PG8_WAIT_V(4); PG8_BAR;
        PG8_STAGE(PG8_SB(1, 0), cB + kstep, voffB); PG8_STAGE(PG8_SA(1, 0), cA + kstep, voffA); PG8_STAGE(PG8_SB(1, 1), cB + hstep + kstep, voffB);
        PG8_WAIT_V(6); PG8_BAR;
    }
    for (;;) {
        const bool has_next = S.next(ui + 1, nxt);
        const char* nA = has_next ? (const char*)g.A + (size_t)nxt.pm * tstep : cA; const char* nB = has_next ? (const char*)g.Bt + (size_t)nxt.pn * tstep : cB;
        for (int t = 0; t < nt; t += 2) {
            const bool last = (t == nt - 2);
            const char* a1 = cA + (size_t)(t + 1) * kstep;
            const char* a2 = last ? nA : cA + (size_t)(t + 2) * kstep; const char* b2 = last ? nB : cB + (size_t)(t + 2) * kstep;
            const char* a3 = a2 + kstep; const char* b3 = b2 + kstep;
            if (last && has_next) S.a_ready(nxt);
            if constexpr (SP2) {
            PG8_LDB(B0, 0, 0); PG8_LDB(B1, 0, 1); PG8_SCHED; PG8_LDA(At, 0, 0); PG8_STAGE(PG8_SA(1, 1), a1 + hstep, voffA);
            PG8_WAIT_V(8); PG8_WAIT_L(0); PG8_BAR; PG8_MMA(0, 0, At, B0); PG8_MMA(0, 1, At, B1); PG8_BAR; PG8_SCHED;
            PG8_LDA(At, 0, 1); PG8_STAGE(PG8_SB(0, 0), b2, voffB); PG8_STAGE(PG8_SB(0, 1), b2 + hstep, voffB); PG8_STAGE(PG8_SA(0, 0), a2, voffA);
            PG8_WAIT_V(8); PG8_WAIT_L(0); PG8_BAR; PG8_MMA(1, 0, At, B0); PG8_MMA(1, 1, At, B1); PG8_BAR; PG8_SCHED;
            PG8_LDB(B0, 1, 0); PG8_LDB(B1, 1, 1); PG8_SCHED; PG8_LDA(At, 1, 0); PG8_STAGE(PG8_SA(0, 1), a2 + hstep, voffA);
            PG8_WAIT_V(8); PG8_WAIT_L(0); PG8_BAR; PG8_MMA(0, 0, At, B0); PG8_MMA(0, 1, At, B1); PG8_BAR; PG8_SCHED;
            PG8_LDA(At, 1, 1); PG8_STAGE(PG8_SB(1, 0), b3, voffB); PG8_STAGE(PG8_SB(1, 1), b3 + hstep, voffB); PG8_STAGE(PG8_SA(1, 0), a3, voffA);
            PG8_WAIT_V(8); PG8_WAIT_L(0); PG8_BAR; PG8_MMA(1, 0, At, B0); PG8_MMA(1, 1, At, B1); PG8_BAR; PG8_SCHED;
            } else {
            PG8_LDB(B0, 0, 0); PG8_SCHED; PG8_LDA(At, 0, 0); PG8_STAGE(PG8_SA(1, 1), a1 + hstep, voffA);
            PG8_WAIT_L(8); PG8_BAR; PG8_WAIT_L(0); PG8_MMA(0, 0, At, B0); PG8_BAR; PG8_SCHED;
            PG8_LDB(B1, 0, 1); PG8_STAGE(PG8_SB(0, 0), b2, voffB);
            PG8_BAR; PG8_WAIT_L(0); PG8_MMA(0, 1, At, B1); PG8_BAR;
            PG8_LDA(At, 0, 1); PG8_STAGE(PG8_SA(0, 0), a2, voffA);
            PG8_BAR; PG8_WAIT_L(0); PG8_MMA(1, 0, At, B0); PG8_BAR; PG8_SCHED;
            PG8_STAGE(PG8_SB(0, 1), b2 + hstep, voffB);
            PG8_WAIT_V(6); PG8_BAR; PG8_MMA(1, 1, At, B1); PG8_BAR;
            PG8_LDB(B0, 1, 0); PG8_SCHED; PG8_LDA(At, 1, 0); PG8_STAGE(PG8_SA(0, 1), a2 + hstep, voffA);
            PG8_WAIT_L(8); PG8_BAR; PG8_WAIT_L(0); PG8_MMA(0, 0, At, B0); PG8_BAR; PG8_SCHED;
            PG8_LDB(B1, 1, 1); PG8_STAGE(PG8_SB(1, 0), b3, voffB);
            PG8_BAR; PG8_WAIT_L(0); PG8_MMA(0, 1, At, B1); PG8_BAR;
            PG8_LDA(At, 1, 1); PG8_STAGE(PG8_SA(1, 0), a3, voffA);
            PG8_BAR; PG8_WAIT_L(0); PG8_MMA(1, 0, At, B0); PG8_BAR; PG8_SCHED;
            PG8_STAGE(PG8_SB(1, 1), b3 + hstep, voffB);
            PG8_WAIT_V(6); PG8_BAR; PG8_MMA(1, 1, At, B1); PG8_BAR;
            }
        }
        if constexpr (ALIGN_EPI) { if (wr == 0) PG8_BAR; }
        if constexpr (!Epi::AFTER_DRAIN) { E(acc, cur, wr, wc, fr, fq); S.done(cur); }
        if (!has_next) break;
#pragma unroll
        for (int a = 0; a < 2; ++a)
#pragma unroll
            for (int b = 0; b < 2; ++b)
#pragma unroll
                for (int m = 0; m < 4; ++m)
#pragma unroll
                    for (int n = 0; n < 2; ++n) acc[a][b][m][n] = (f32x4){0.f, 0.f, 0.f, 0.f};
        cur = nxt; cA = nA; cB = nB; ++ui;
        if constexpr (ALIGN_EPI) { if (wr == 1) PG8_BAR; }
    }
    PG8_WAIT_V(0);
    if constexpr (!ALIGN_EPI) { if (wr == 0) PG8_BAR; }
    PG8_BAR;
    if constexpr (Epi::AFTER_DRAIN) { E.fused(acc, cur, wr, wc, fr, fq, lds, wid, lane); S.done(cur); }
#undef PG8_SA
#undef PG8_SB
#undef PG8_STAGE
#undef PG8_LDA
#undef PG8_LDB
#undef PG8_MMA
#undef PG8_WAIT_V
#undef PG8_WAIT_L
#undef PG8_BAR
#undef PG8_SCHED
}
}

namespace pg8 {
constexpr float RMS_EPS = 1e-6f;
constexpr float C2 = 0.125f * 1.4426950408889634f;
typedef __bf16 bf16x2_t __attribute__((ext_vector_type(2)));
__device__ __forceinline__ unsigned pkbf(float lo, float hi) { f32x2 v = {lo, hi}; bf16x2_t b = __builtin_convertvector(v, bf16x2_t); return __builtin_bit_cast(unsigned, b); }
__device__ __forceinline__ float rstd_row(const float* ss, int row, float inv_n) { return __builtin_amdgcn_rsqf(ss[row] * inv_n + RMS_EPS); }

struct EpiSwiGLU {
    static constexpr bool PERM = true, AFTER_DRAIN = false;
    bf16_t* H; const float* ss; int ldh;
    __device__ __forceinline__ void operator()(const f32x4 (&acc)[2][2][4][2], const Unit& u, int wr, int wc, int fr, int fq) const {
        const int row0 = u.pm * BM + wr * 64 + fr, col0 = u.pn * HALF + wc * 32 + 8 * fq;
#pragma unroll
        for (int ai = 0; ai < 2; ++ai)
#pragma unroll
            for (int m = 0; m < 4; ++m) { const int row = row0 + ai * HALF + m * 16; const float r = rstd_row(ss, row, 1.0f / 1024.0f);
                u32x4 w;
#pragma unroll
                for (int n = 0; n < 2; ++n) { const f32x4 g = acc[ai][0][m][n] * r, up = acc[ai][1][m][n] * r; float hv[4];
#pragma unroll
                    for (int e = 0; e < 4; ++e) { const float sg = g[e] * __builtin_amdgcn_rcpf(1.0f + __builtin_amdgcn_exp2f(-1.4426950408889634f * g[e])); hv[e] = sg * up[e]; }
                    w[2 * n] = pkbf(hv[0], hv[1]); w[2 * n + 1] = pkbf(hv[2], hv[3]); }
                *(u32x4*)(H + (size_t)row * ldh + col0) = w; }
    }
};
template <bool WXB> struct EpiResid {
    static constexpr bool PERM = false, AFTER_DRAIN = false;
    const float* xin; float* xout; bf16_t* xb; float* ss; float alpha;
    __device__ __forceinline__ void operator()(const f32x4 (&acc)[2][2][4][2], const Unit& u, int wr, int wc, int fr, int fq) const {
        typedef unsigned u32x2v __attribute__((ext_vector_type(2)));
        const int row0 = u.pm * BM + wr * 64 + fr, col0 = u.pn * BM + wc * 32 + 4 * fq;
#pragma unroll
        for (int ai = 0; ai < 2; ++ai)
#pragma unroll
            for (int m = 0; m < 4; ++m) { const int row = row0 + ai * HALF + m * 16; const size_t off = (size_t)row * 1024 + col0; float q = 0.f;
#pragma unroll
                for (int bj = 0; bj < 2; ++bj)
#pragma unroll
                    for (int n = 0; n < 2; ++n) { const f32x4 b = *(const f32x4*)(xin + off + bj * HALF + n * 16); const f32x4 v = b + acc[ai][bj][m][n] * alpha;
                        *(f32x4*)(xout + off + bj * HALF + n * 16) = v; q += (v[0] * v[0] + v[1] * v[1]) + (v[2] * v[2] + v[3] * v[3]);
                        if (WXB) { u32x2v w; w.x = pkbf(v[0], v[1]); w.y = pkbf(v[2], v[3]); *(u32x2v*)(xb + off + bj * HALF + n * 16) = w; } }
                q += __shfl_xor(q, 16); q += __shfl_xor(q, 32);
                if (fq == 0) atomicAdd(ss + row, q); }
    }
};
__device__ __forceinline__ void sincos_big(float ang, float& s, float& c) {
    const float CH = 0.15915493667125702f, CL = 6.4206382432985265e-09f;
    const float hi = ang * CH; const float lo = __builtin_fmaf(ang, CH, -hi) + ang * CL;
    const float x = __builtin_amdgcn_fractf(hi) + lo;
    s = __builtin_amdgcn_sinf(x); c = __builtin_amdgcn_cosf(x);
}
struct EpiQKV {
    static constexpr bool PERM = true, AFTER_DRAIN = false;
    bf16_t* O; const float* ss;
    __device__ __forceinline__ void operator()(const f32x4 (&acc)[2][2][4][2], const Unit& u, int wr, int wc, int fr, int fq) const {
        const int type = u.pn >> 1; const float qs = (type == 0 || type == 3) ? C2 : 1.0f;
        const int row0 = u.pm * BM + wr * 64 + fr;
        if (type == 3 || type == 4) {
            float invf[8];
#pragma unroll
            for (int j = 0; j < 8; ++j) invf[j] = exp2f(-(float)(8 * fq + j) * 0.4152410118609203f);
            const int col0 = u.pn * BM + wc * 64 + 8 * fq;
#pragma unroll
            for (int ai = 0; ai < 2; ++ai)
#pragma unroll
                for (int m = 0; m < 4; ++m) { const int row = row0 + ai * HALF + m * 16; const float r = rstd_row(ss, row, 1.0f / 1024.0f) * qs; const float fpos = (float)(row & 8191);
                    u32x4 w1, w2; float o1[8], o2[8];
#pragma unroll
                    for (int n = 0; n < 2; ++n)
#pragma unroll
                        for (int e = 0; e < 4; ++e) { float s, c; sincos_big(fpos * invf[4 * n + e], s, c); const float t1 = acc[ai][0][m][n][e] * r, t2 = acc[ai][1][m][n][e] * r;
                            o1[4 * n + e] = t1 * c - t2 * s; o2[4 * n + e] = t2 * c + t1 * s; }
#pragma unroll
                    for (int j = 0; j < 4; ++j) { w1[j] = pkbf(o1[2 * j], o1[2 * j + 1]); w2[j] = pkbf(o2[2 * j], o2[2 * j + 1]); }
                    bf16_t* rowp = O + (size_t)row * 3072 + col0; *(u32x4*)rowp = w1; *(u32x4*)(rowp + 32) = w2; }
        } else {
            const int col0 = u.pn * BM + wc * 32 + 8 * fq;
#pragma unroll
            for (int ai = 0; ai < 2; ++ai)
#pragma unroll
                for (int m = 0; m < 4; ++m) { const int row = row0 + ai * HALF + m * 16; const float r = rstd_row(ss, row, 1.0f / 1024.0f) * qs; bf16_t* rowp = O + (size_t)row * 3072 + col0;
#pragma unroll
                    for (int bj = 0; bj < 2; ++bj) { const f32x4 v0 = acc[ai][bj][m][0] * r, v1 = acc[ai][bj][m][1] * r; u32x4 w; w.x = pkbf(v0[0], v0[1]); w.y = pkbf(v0[2], v0[3]); w.z = pkbf(v1[0], v1[1]); w.w = pkbf(v1[2], v1[3]);
                        *(u32x4*)(rowp + bj * HALF) = w; } }
        }
    }
};
}

namespace att {
#define ATT_LAS __attribute__((address_space(3)))
typedef unsigned short bf16_t;
typedef short bf16x8 __attribute__((ext_vector_type(8)));
typedef short s16x4 __attribute__((ext_vector_type(4)));
typedef float f32x16 __attribute__((ext_vector_type(16)));
typedef unsigned u32x4 __attribute__((ext_vector_type(4)));
typedef unsigned u32x2 __attribute__((ext_vector_type(2)));
constexpr int SEQ = 8192, LDQ = 3072;
constexpr float SB_EXIT = -30.0f;
__device__ __forceinline__ float swap_other(float v, int h2) { auto rr = __builtin_amdgcn_permlane32_swap(__float_as_uint(v), __float_as_uint(v), false, false); return __uint_as_float(h2 ? rr[0] : rr[1]); }
__device__ __forceinline__ s16x4 vtr(const ATT_LAS char* p) { return __builtin_bit_cast(s16x4, __builtin_amdgcn_ds_read_tr16_b64_v4i16((ATT_LAS s16x4*)p)); }

template <bool SBK> __device__ __forceinline__ void item(const bf16_t* __restrict__ QKV, int b, int h, int dil, int c, int i0, ATT_LAS char* vl, bf16_t* O, float* LSE) {
    const int lane = threadIdx.x & 63, r = lane & 31, h2 = lane >> 5;
    const int qc = (SBK ? 0 : 1536) + h * 64, kc = qc + 512, vc = qc + 1024;
    const size_t rowb = (size_t)b * SEQ + c;
    bf16x8 qf[4];
    { const bf16_t* qp = QKV + (rowb + (size_t)(i0 + r) * dil) * LDQ + qc + 8 * h2;
#pragma unroll
      for (int s = 0; s < 4; ++s) qf[s] = *(const bf16x8*)(qp + 16 * s); }
    const int kbhi = i0 >> 5, kblo = SBK ? 0 : (kbhi - 4 > 0 ? kbhi - 4 : 0);
    f32x16 o0, o1;
#pragma unroll
    for (int i = 0; i < 16; ++i) { o0[i] = 0.f; o1[i] = 0.f; }
    float R = 0.f;
    float mrun = -1e30f, lrun = 0.f;
    bf16x8 kf[4]; u32x4 vr[4];
    auto loadkv = [&](int kb, bf16x8 (&kq)[4], u32x4 (&vq)[4]) {
        const bf16_t* kp = QKV + (rowb + (size_t)(32 * kb + r) * dil) * LDQ + kc + 8 * h2;
#pragma unroll
        for (int s = 0; s < 4; ++s) kq[s] = *(const bf16x8*)(kp + 16 * s);
#pragma unroll
        for (int i = 0; i < 4; ++i) { const int id = lane + 64 * i, key = id >> 3, ch = id & 7; vq[i] = *(const u32x4*)(QKV + (rowb + (size_t)(32 * kb + key) * dil) * LDQ + vc + 8 * ch); }
    };
    loadkv(kbhi, kf, vr);
    int buf = 0;
    const int tro = (4 * h2 + ((lane & 15) >> 2)) * 64 + ((lane >> 4) & 1) * 32 + (lane & 3) * 8;
    for (int kb = kbhi; kb >= kblo; --kb) {
        ATT_LAS char* vb = vl + buf * 4096;
#pragma unroll
        for (int i = 0; i < 4; ++i) { const int id = lane + 64 * i, key = id >> 3, ch = id & 7; *(ATT_LAS u32x4*)(vb + (ch >> 2) * 2048 + key * 64 + (ch & 3) * 16) = vr[i]; }
        bf16x8 kc4[4];
#pragma unroll
        for (int s = 0; s < 4; ++s) kc4[s] = kf[s];
        if (kb > kblo) loadkv(kb - 1, kf, vr);
        f32x16 st;
#pragma unroll
        for (int i = 0; i < 16; ++i) st[i] = 0.f;
#pragma unroll
        for (int s = 0; s < 4; ++s) st = __builtin_amdgcn_mfma_f32_32x32x16_bf16(kc4[s], qf[s], st, 0, 0, 0);
        const int dbase = (i0 - 32 * kb) + r - 4 * h2;
        float p[16];
        if (SBK) {
            float ls[16];
#pragma unroll
            for (int i = 0; i < 16; ++i) { const int dist = dbase - ((i & 3) + 8 * (i >> 2)); const float z = st[i];
                const float e = __builtin_amdgcn_exp2f(-__builtin_fabsf(z)); const float sp = __builtin_fmaxf(z, 0.f) + __builtin_amdgcn_logf(1.0f + e);
                ls[i] = dist >= 1 ? -sp : 0.f; }
            float rs[4], ot[4];
#pragma unroll
            for (int g = 0; g < 4; ++g) { ls[4 * g + 2] += ls[4 * g + 3]; ls[4 * g + 1] += ls[4 * g + 2]; ls[4 * g] += ls[4 * g + 1]; rs[g] = ls[4 * g]; }
#pragma unroll
            for (int g = 0; g < 4; ++g) ot[g] = swap_other(rs[g], h2);
            float after = R;
#pragma unroll
            for (int g = 3; g >= 0; --g) { const float off = after + (h2 == 0 ? ot[g] : 0.f);
#pragma unroll
                for (int e = 0; e < 4; ++e) { const int i = 4 * g + e; const int dist = dbase - ((i & 3) + 8 * (i >> 2)); p[i] = dist >= 1 ? __builtin_amdgcn_exp2f(st[i] + ls[i] + off) : 0.f; }
                after += rs[g] + ot[g]; }
            R = after;
        } else {
            float mx = -1e30f;
#pragma unroll
            for (int i = 0; i < 16; ++i) { const int dist = dbase - ((i & 3) + 8 * (i >> 2)); const bool ok = (unsigned)dist <= 128u; st[i] = ok ? st[i] : -1e30f; mx = __builtin_fmaxf(mx, st[i]); }
            mx = __builtin_fmaxf(mx, swap_other(mx, h2));
            const float mnew = __builtin_fmaxf(mrun, mx); const float alpha = __builtin_amdgcn_exp2f(mrun - mnew); mrun = mnew;
            float sum = 0.f;
#pragma unroll
            for (int i = 0; i < 16; ++i) { p[i] = __builtin_amdgcn_exp2f(st[i] - mnew); sum += p[i]; }
            lrun = lrun * alpha + sum;
#pragma unroll
            for (int i = 0; i < 16; ++i) { o0[i] *= alpha; o1[i] *= alpha; }
        }
        bf16x8 pb[2];
#pragma unroll
        for (int s = 0; s < 2; ++s) { u32x4 w; w.x = pg8::pkbf(p[8 * s], p[8 * s + 1]); w.y = pg8::pkbf(p[8 * s + 2], p[8 * s + 3]); w.z = pg8::pkbf(p[8 * s + 4], p[8 * s + 5]); w.w = pg8::pkbf(p[8 * s + 6], p[8 * s + 7]); pb[s] = __builtin_bit_cast(bf16x8, w); }
        asm volatile("s_waitcnt lgkmcnt(0)" ::: "memory");
#pragma unroll
        for (int s = 0; s < 2; ++s) {
            const s16x4 a0 = vtr(vb + tro + (16 * s) * 64), a1 = vtr(vb + tro + (16 * s + 8) * 64);
            const s16x4 b0 = vtr(vb + 2048 + tro + (16 * s) * 64), b1 = vtr(vb + 2048 + tro + (16 * s + 8) * 64);
            const bf16x8 va = __builtin_shufflevector(a0, a1, 0, 1, 2, 3, 4, 5, 6, 7), vbb = __builtin_shufflevector(b0, b1, 0, 1, 2, 3, 4, 5, 6, 7);
            o0 = __builtin_amdgcn_mfma_f32_32x32x16_bf16(va, pb[s], o0, 0, 0, 0);
            o1 = __builtin_amdgcn_mfma_f32_32x32x16_bf16(vbb, pb[s], o1, 0, 0, 0);
        }
        buf ^= 1;
        if (SBK) { if (__all(R < SB_EXIT)) break; }
    }
    float sc = 1.f;
    if (!SBK) { const float lt = lrun + swap_other(lrun, h2); sc = __builtin_amdgcn_rcpf(lt); if (h2 == 0) LSE[((size_t)rowb + (size_t)(i0 + r) * dil) * 8 + h] = mrun + __builtin_amdgcn_logf(lt); }
    bf16_t* op = O + (rowb + (size_t)(i0 + r) * dil) * 512 + h * 64 + 4 * h2;
#pragma unroll
    for (int g = 0; g < 4; ++g) { u32x2 w0, w1; w0.x = pg8::pkbf(o0[4 * g] * sc, o0[4 * g + 1] * sc); w0.y = pg8::pkbf(o0[4 * g + 2] * sc, o0[4 * g + 3] * sc);
        w1.x = pg8::pkbf(o1[4 * g] * sc, o1[4 * g + 1] * sc); w1.y = pg8::pkbf(o1[4 * g + 2] * sc, o1[4 * g + 3] * sc);
        *(u32x2*)(op + 8 * g) = w0; *(u32x2*)(op + 32 + 8 * g) = w1; }
}
}

constexpr int NWAVES = 8;
constexpr int BATCH = 2, SEQ = 8192, DM = 1024, DFF = 2816, DIN = 3072, M = BATCH * SEQ;
constexpr size_t MiB = 1u << 20;
constexpr size_t WS_SS = 0;
constexpr size_t WS_BAR = 512 * 1024, BAR_BYTES = 16384;
constexpr size_t WS_WGU1 = 1 * MiB, WS_WD1 = 12 * MiB, WS_WIN = 18 * MiB, WS_WOUT = 24 * MiB, WS_WGU2 = 26 * MiB, WS_WD2 = 37 * MiB;
constexpr size_t WS_XA = 43 * MiB, WS_XB = 75 * MiB;
constexpr size_t WS_H = 107 * MiB;
constexpr size_t WS_ODL = 203 * MiB;
constexpr size_t WS_OSB = WS_XB, WS_LSE = WS_XB + 16 * MiB;
constexpr size_t WS_END = 251 * MiB;
static_assert(WS_WD2 + (size_t)DM * DFF * 2 <= WS_XA && WS_H + (size_t)M * DIN * 2 <= WS_ODL && WS_ODL + (size_t)3 * M * 512 * 2 <= WS_END, "d_ws map");
constexpr int RING_BYTES = 131072, LDS_BYTES = 147456;

#define GAS __attribute__((address_space(1)))
#define LAS __attribute__((address_space(3)))
typedef unsigned short bf16;
typedef unsigned v4u __attribute__((ext_vector_type(4)));
typedef float f32x4 __attribute__((ext_vector_type(4)));
#define LDS_WAIT() asm volatile("s_waitcnt lgkmcnt(0)" ::: "memory")
using pg8::pkbf;
#define RLX_AGENT __ATOMIC_RELAXED, __HIP_MEMORY_SCOPE_AGENT
#define XB_TMO      128
#define XB_XCNT(j)  (256  + 64 * (j))
#define XB_XSUB(j)  (1280 + 64 * (j))
#define XB_XGEN(j)  (2304 + 64 * (j))
#define XB_TOP      3328
#define XB_TOPGEN   3392
#define XCD_BAR_WORDS 3456
#define XB_SPIN_CAP (1u << 18)

__device__ __forceinline__ unsigned xb_ld(unsigned* p)              { return __hip_atomic_load(p, __ATOMIC_RELAXED, __HIP_MEMORY_SCOPE_AGENT); }
__device__ __forceinline__ unsigned xb_add(unsigned* p, unsigned v) { return __hip_atomic_fetch_add(p, v, __ATOMIC_RELAXED, __HIP_MEMORY_SCOPE_AGENT); }
__device__ __forceinline__ unsigned xb_xcc_id() { return (unsigned)__builtin_amdgcn_s_getreg((3 << 11) | 20) & 0xFu; }
#define XB_SPIN(cond, bar) do { unsigned _sp = 0; while (cond) { __builtin_amdgcn_s_sleep(1); \
    if ((++_sp & 255u) == 0u) { if (xb_ld(&(bar)[XB_TMO])) break; if (_sp > XB_SPIN_CAP) { atomicAdd(&(bar)[XB_TMO], 1u); break; } } } } while (0)

struct XcdBarrier {
    unsigned* bar; unsigned x;
    volatile LAS unsigned* st;
};

__device__ __forceinline__ XcdBarrier xcd_barrier_post(unsigned* bar, volatile LAS unsigned* st) {
    XcdBarrier b; b.bar = bar; b.x = xb_xcc_id(); b.st = st;
    if (threadIdx.x == 0) (void)xb_add(&bar[XB_XCNT(b.x)], 1u);
    return b;
}
__device__ __forceinline__ void xcd_barrier_complete(unsigned* bar, unsigned x, unsigned& nloc, unsigned& nx) {
    const unsigned G = gridDim.x * gridDim.y * gridDim.z;
    unsigned sum, cnt, mine, sp = 0u;
    for (;;) {
        sum = 0u; cnt = 0u; mine = 0u;
#pragma unroll
        for (unsigned j = 0; j < 16; ++j) { const unsigned c = xb_ld(&bar[XB_XCNT(j)]); sum += c; cnt += (c > 0u) ? 1u : 0u; mine = (j == x) ? c : mine; }
        if (sum == G) break;
        __builtin_amdgcn_s_sleep(1);
        if ((++sp & 255u) == 0u) { if (xb_ld(&bar[XB_TMO])) break; if (sp > XB_SPIN_CAP) { atomicAdd(&bar[XB_TMO], 1u); break; } }
    }
    nloc = mine > 0u ? mine : 1u; nx = cnt > 0u ? cnt : 1u;
}

__device__ __forceinline__ void xcd_barrier(const XcdBarrier& b) {
    asm volatile("s_waitcnt vmcnt(0)" ::: "memory");
    __syncthreads();
    if (threadIdx.x == 0) {
        unsigned* bar = b.bar;
        __builtin_amdgcn_s_waitcnt(0);
        unsigned nloc = b.st[0], nx = b.st[1];
        if (nloc == 0u) { xcd_barrier_complete(bar, b.x, nloc, nx); b.st[0] = nloc; b.st[1] = nx; }
        const unsigned old = xb_add(&bar[XB_XSUB(b.x)], 1u);
        const unsigned gen = old / nloc;
        if (old + 1u == (gen + 1u) * nloc) {
            __builtin_amdgcn_fence(__ATOMIC_RELEASE, "agent");
            asm volatile("s_waitcnt vmcnt(0)" ::: "memory");
            const unsigned og = xb_add(&bar[XB_TOP], 1u);
            const unsigned tg = og / nx;
            if (og + 1u == (tg + 1u) * nx) xb_add(&bar[XB_TOPGEN], 1u);
            else XB_SPIN(xb_ld(&bar[XB_TOPGEN]) == tg, bar);
            __builtin_amdgcn_fence(__ATOMIC_ACQUIRE, "agent");
            xb_add(&bar[XB_XGEN(b.x)], 1u);
            asm volatile("s_waitcnt vmcnt(0)" ::: "memory");
        } else {
            XB_SPIN(xb_ld(&bar[XB_XGEN(b.x)]) == gen, bar);
            __builtin_amdgcn_fence(__ATOMIC_ACQUIRE, "agent");
            asm volatile("s_waitcnt vmcnt(0)" ::: "memory");
        }
    }
    __syncthreads();
}


__device__ __forceinline__ float wave_sum(float v) {
#pragma unroll
    for (int o = 1; o < 64; o <<= 1) v += __shfl_xor(v, o);
    return v;
}
__device__ __forceinline__ void p0_item(const float* W, int ldw, int col0, int k0, const float* gain, bf16* WT, int K, int drow0, LAS float* scr, int lane) {
    float tv[32];
#pragma unroll
    for (int i = 0; i < 32; ++i) { const int kk = 2 * i + (lane >> 5); tv[i] = W[(size_t)(k0 + kk) * ldw + col0 + (lane & 31)]; }
    if (gain) {
#pragma unroll
        for (int i = 0; i < 32; ++i) tv[i] *= gain[k0 + 2 * i + (lane >> 5)]; }
#pragma unroll
    for (int i = 0; i < 32; ++i) scr[(2 * i + (lane >> 5)) * 33 + (lane & 31)] = tv[i];
    LDS_WAIT(); asm volatile("" ::: "memory");
    const int c = lane & 7;
#pragma unroll
    for (int j = 0; j < 4; ++j) { const int n = (lane >> 3) + 8 * j; const LAS float* s = scr + (8 * c) * 33 + n;
        v4u o; o.x = pkbf(s[0 * 33], s[1 * 33]); o.y = pkbf(s[2 * 33], s[3 * 33]); o.z = pkbf(s[4 * 33], s[5 * 33]); o.w = pkbf(s[6 * 33], s[7 * 33]);
        *(v4u*)(WT + (size_t)(drow0 + n) * K + k0 + 8 * c) = o; }
    LDS_WAIT(); asm volatile("" ::: "memory");
}
__device__ __forceinline__ void p0_mat(int it, int kind, const float* s0, const float* s1, const float* gain, bf16* dst, int K, int Nd, int ldw, LAS float* scr, int lane) {
    const int nblk = Nd / 32, kb = it / nblk, nb = it % nblk; int col0 = 32 * nb; const float* src = s0;
    if (kind == 1) { const int pn = nb >> 3, half = (nb >> 2) & 1, o32 = nb & 3; src = half ? s1 : s0; col0 = 128 * pn + 32 * o32; }
    else if (kind == 2) { const int n0 = 32 * nb; if (n0 >= 1536 && n0 < 2560) { const int tl = (n0 - 1536) & 255, tb = n0 - tl, half = tl >> 7, hd = (tl & 127) >> 5; col0 = tb + 64 * hd + 32 * half; } }
    p0_item(src, ldw, col0, 64 * kb, gain, dst, K, 32 * nb, scr, lane);
}

struct Args { const float* in[15]; float* out; unsigned char* ws; int ph_lo, ph_hi; };

__global__ void __launch_bounds__(NWAVES * 64, 2) fwd_mega(Args a) {
    extern __shared__ __attribute__((aligned(16))) unsigned char lds_raw[];
    LAS unsigned char* lds = (LAS unsigned char*)lds_raw;
    const int tid = threadIdx.x, lane = tid & 63, wave = __builtin_amdgcn_readfirstlane(tid >> 6);
    const int G = gridDim.x, bx = blockIdx.x, vcu = (G % 8 == 0) ? (bx % 8) * (G / 8) + bx / 8 : bx;
    const int gw = vcu * NWAVES + wave, NGW = G * NWAVES;
    unsigned char* ws = a.ws;
    const float* x = a.in[0];
    float* ss1 = (float*)(ws + WS_SS); float* ss2 = ss1 + M; float* ss3 = ss2 + M; float* ss4 = ss3 + M;
    bf16* Wgu1 = (bf16*)(ws + WS_WGU1); bf16* Wd1 = (bf16*)(ws + WS_WD1); bf16* Win = (bf16*)(ws + WS_WIN); bf16* Wout = (bf16*)(ws + WS_WOUT); bf16* Wgu2 = (bf16*)(ws + WS_WGU2); bf16* Wd2 = (bf16*)(ws + WS_WD2);
    bf16* XA = (bf16*)(ws + WS_XA); bf16* XB = (bf16*)(ws + WS_XB); bf16* HB = (bf16*)(ws + WS_H); bf16* QKV = HB;
    bf16* ODL = (bf16*)(ws + WS_ODL); bf16* OSB = (bf16*)(ws + WS_OSB); float* LSE = (float*)(ws + WS_LSE);
    float* out = a.out;
    const int lo = a.ph_lo, hi = a.ph_hi;
    cg::grid_group grid = cg::this_grid();
    volatile LAS unsigned* bst = (volatile LAS unsigned*)(lds + RING_BYTES + 64);
    if (tid == 0) { bst[0] = 0u; bst[1] = 0u; }
    __syncthreads();
    XcdBarrier bar = xcd_barrier_post((unsigned*)(ws + WS_BAR), bst);
#define IN(k) (lo <= (k) && (k) < hi)
#define SEAM(k) do { if (IN(k) && IN((k) + 1)) { if (lo < 0) grid.sync(); else xcd_barrier(bar); } } while (0)

    if (IN(0)) {
        LAS float* scr = (LAS float*)(lds + wave * 16384);
        constexpr int I_GU = (DM / 64) * (2 * DFF / 32), I_D = (DFF / 64) * (DM / 32), I_IN = (DM / 64) * (DIN / 32), I_OUT = (DM / 64) * (DM / 32);
        constexpr int NITEMS = 2 * I_GU + 2 * I_D + I_IN + I_OUT;
        for (int it = gw; it < NITEMS; it += NGW) {
            int r = it;
            if (r < I_GU) { p0_mat(r, 1, a.in[2], a.in[3], a.in[1], Wgu1, DM, 2 * DFF, DFF, scr, lane); continue; } r -= I_GU;
            if (r < I_D) { p0_mat(r, 0, a.in[4], nullptr, nullptr, Wd1, DFF, DM, DM, scr, lane); continue; } r -= I_D;
            if (r < I_IN) { p0_mat(r, 2, a.in[6], nullptr, a.in[5], Win, DM, DIN, DIN, scr, lane); continue; } r -= I_IN;
            if (r < I_OUT) { p0_mat(r, 0, a.in[9], nullptr, nullptr, Wout, DM, DM, DM, scr, lane); continue; } r -= I_OUT;
            if (r < I_GU) { p0_mat(r, 1, a.in[11], a.in[12], a.in[10], Wgu2, DM, 2 * DFF, DFF, scr, lane); continue; } r -= I_GU;
            p0_mat(r, 0, a.in[13], nullptr, nullptr, Wd2, DFF, DM, DM, scr, lane);
        }
        for (int m0 = gw; m0 < M; m0 += 4 * NGW) {
            f32x4 v[4][4];
#pragma unroll
            for (int u = 0; u < 4; ++u) { const int m = m0 + u * NGW; if (m < M) { const f32x4* xr = (const f32x4*)(x + (size_t)m * DM) + lane;
#pragma unroll
                for (int j = 0; j < 4; ++j) v[u][j] = xr[64 * j]; } }
#pragma unroll
            for (int u = 0; u < 4; ++u) { const int m = m0 + u * NGW; if (m < M) { float s = 0.f;
#pragma unroll
                for (int j = 0; j < 4; ++j) s += (v[u][j].x * v[u][j].x + v[u][j].y * v[u][j].y) + (v[u][j].z * v[u][j].z + v[u][j].w * v[u][j].w);
                s = wave_sum(s);
                unsigned long long* o8 = (unsigned long long*)(XA + (size_t)m * DM) + lane;
#pragma unroll
                for (int j = 0; j < 4; ++j) o8[64 * j] = (unsigned long long)pkbf(v[u][j].x, v[u][j].y) | ((unsigned long long)pkbf(v[u][j].z, v[u][j].w) << 32);
                if (lane == 0) { ss1[m] = s; ss2[m] = 0.f; ss3[m] = 0.f; ss4[m] = 0.f; } } }
        }
    }
    SEAM(0);
    if (IN(1)) { pg8::Gemm g{XA, Wgu1, M, 2 * DFF, DM}; pg8::StaticOrder S; S.init(M, 2 * DFF, G, bx); pg8::EpiSwiGLU E{HB, ss1, DFF};
        pg8::gemm_phase<pg8::EpiSwiGLU, pg8::StaticOrder, true, true>(lds, g, S, E); }
    SEAM(1);
    if (IN(2)) { pg8::Gemm g{HB, Wd1, M, DM, DFF}; pg8::StaticOrder S; S.init(M, DM, G, bx); pg8::EpiResid<true> E{x, out, XB, ss2, 0.5f};
        pg8::gemm_phase<pg8::EpiResid<true>, pg8::StaticOrder, true, true>(lds, g, S, E); }
    SEAM(2);
    if (IN(3)) { pg8::Gemm g{XB, Win, M, DIN, DM}; pg8::StaticOrder S; S.init(M, DIN, G, bx); pg8::EpiQKV E{QKV, ss2};
        pg8::gemm_phase<pg8::EpiQKV, pg8::StaticOrder, true, true>(lds, g, S, E); }
    SEAM(3);
    if (IN(4)) {
        LAS char* vl = (LAS char*)(lds + wave * 8192);
        for (int it = gw; it < 16384; it += NGW) {
            const int p = it >> 12, rem = it & 4095, bh = rem >> 8, bl = rem & 255, b = bh >> 3, h = bh & 7;
            if (p == 0) att::item<true>(QKV, b, h, 1, 0, 32 * bl, vl, OSB, nullptr);
            else { const int sh = (p == 1) ? 0 : (p == 2 ? 2 : 4), dil = 1 << sh, bpc = 256 >> sh, c = bl / bpc, blk = bl % bpc;
                att::item<false>(QKV, b, h, dil, c, 32 * blk, vl, ODL + (size_t)(p - 1) * M * 512, LSE + (size_t)(p - 1) * M * 8); }
        }
    }
    SEAM(4);
    if (IN(5)) {
        const float* gsb = a.in[7]; const float* gdl = a.in[8];
        for (int m = gw; m < M; m += NGW) {
            typedef short s16x8 __attribute__((ext_vector_type(8)));
            float v[8], w[8];
            { const s16x8 raw = *(const s16x8*)(OSB + (size_t)m * 512 + 8 * lane);
#pragma unroll
              for (int j = 0; j < 8; ++j) v[j] = __uint_as_float((unsigned)(unsigned short)raw[j] << 16); }
            { const int hh = lane >> 3; float l0 = LSE[(size_t)m * 8 + hh], l1 = LSE[((size_t)M + m) * 8 + hh], l2 = LSE[((size_t)2 * M + m) * 8 + hh];
              const float mx = __builtin_fmaxf(l0, __builtin_fmaxf(l1, l2)); l0 = __builtin_amdgcn_exp2f(l0 - mx); l1 = __builtin_amdgcn_exp2f(l1 - mx); l2 = __builtin_amdgcn_exp2f(l2 - mx);
              const float inv = __builtin_amdgcn_rcpf(l0 + l1 + l2); l0 *= inv; l1 *= inv; l2 *= inv;
              const s16x8 r0 = *(const s16x8*)(ODL + (size_t)m * 512 + 8 * lane), r1 = *(const s16x8*)(ODL + ((size_t)M + m) * 512 + 8 * lane), r2 = *(const s16x8*)(ODL + ((size_t)2 * M + m) * 512 + 8 * lane);
#pragma unroll
              for (int j = 0; j < 8; ++j) w[j] = l0 * __uint_as_float((unsigned)(unsigned short)r0[j] << 16) + l1 * __uint_as_float((unsigned)(unsigned short)r1[j] << 16) + l2 * __uint_as_float((unsigned)(unsigned short)r2[j] << 16); }
            float s1 = 0.f, s2 = 0.f;
#pragma unroll
            for (int j = 0; j < 8; ++j) { s1 += v[j] * v[j]; s2 += w[j] * w[j]; }
            s1 = wave_sum(s1); s2 = wave_sum(s2);
            const float r1 = __builtin_amdgcn_rsqf(s1 * (1.0f / 512.0f) + pg8::RMS_EPS), r2 = __builtin_amdgcn_rsqf(s2 * (1.0f / 512.0f) + pg8::RMS_EPS);
            const f32x4 ga = *(const f32x4*)(gsb + 8 * lane), gb = *(const f32x4*)(gsb + 8 * lane + 4), gc = *(const f32x4*)(gdl + 8 * lane), gd = *(const f32x4*)(gdl + 8 * lane + 4);
            v4u o1, o2;
            o1.x = pkbf(v[0] * r1 * ga.x, v[1] * r1 * ga.y); o1.y = pkbf(v[2] * r1 * ga.z, v[3] * r1 * ga.w); o1.z = pkbf(v[4] * r1 * gb.x, v[5] * r1 * gb.y); o1.w = pkbf(v[6] * r1 * gb.z, v[7] * r1 * gb.w);
            o2.x = pkbf(w[0] * r2 * gc.x, w[1] * r2 * gc.y); o2.y = pkbf(w[2] * r2 * gc.z, w[3] * r2 * gc.w); o2.z = pkbf(w[4] * r2 * gd.x, w[5] * r2 * gd.y); o2.w = pkbf(w[6] * r2 * gd.z, w[7] * r2 * gd.w);
            *(v4u*)(XA + (size_t)m * DM + 8 * lane) = o1; *(v4u*)(XA + (size_t)m * DM + 512 + 8 * lane) = o2;
        }
    }
    SEAM(5);
    if (IN(6)) { pg8::Gemm g{XA, Wout, M, DM, DM}; pg8::StaticOrder S; S.init(M, DM, G, bx); pg8::EpiResid<true> E{out, out, XB, ss3, 1.0f};
        pg8::gemm_phase<pg8::EpiResid<true>, pg8::StaticOrder, true, true>(lds, g, S, E); }
    SEAM(6);
    if (IN(7)) { pg8::Gemm g{XB, Wgu2, M, 2 * DFF, DM}; pg8::StaticOrder S; S.init(M, 2 * DFF, G, bx); pg8::EpiSwiGLU E{HB, ss3, DFF};
        pg8::gemm_phase<pg8::EpiSwiGLU, pg8::StaticOrder, true, true>(lds, g, S, E); }
    SEAM(7);
    if (IN(8)) { pg8::Gemm g{HB, Wd2, M, DM, DFF}; pg8::StaticOrder S; S.init(M, DM, G, bx); pg8::EpiResid<false> E{out, out, nullptr, ss4, 0.5f};
        pg8::gemm_phase<pg8::EpiResid<false>, pg8::StaticOrder, true, true>(lds, g, S, E); }
    SEAM(8);
    if (IN(9)) {
        const float* gf = a.in[14];
        for (int m = gw; m < M; m += NGW) { const float r = __builtin_amdgcn_rsqf(ss4[m] * (1.0f / 1024.0f) + pg8::RMS_EPS); f32x4* xr = (f32x4*)(out + (size_t)m * DM) + lane; const f32x4* gr = (const f32x4*)gf + lane;
#pragma unroll
            for (int j = 0; j < 4; ++j) { const f32x4 v = xr[64 * j], g4 = gr[64 * j]; xr[64 * j] = v * r * g4; } }
    }
#undef IN
#undef SEAM
}

#ifndef N_LAUNCHES
#define N_LAUNCHES 1
#endif
extern "C" void kernel_launch(void* const* d_in, const int* in_sizes, int n_in, void* d_out, int out_size, void* d_ws, size_t ws_size, hipStream_t stream) {
    static int grid = 0;
    if (grid == 0) {
        if (n_in != 15 || in_sizes[0] != M * DM || out_size != M * DM || ws_size < WS_END) { fprintf(stderr, "kernel_launch: unexpected shapes / workspace (n_in %d, ws %zu)\n", n_in, ws_size); grid = -1; return; }
        int dev = 0, cus = 0, per_cu = 0;
        hipGetDevice(&dev); hipDeviceGetAttribute(&cus, hipDeviceAttributeMultiprocessorCount, dev);
        if (hipFuncSetAttribute((const void*)fwd_mega, hipFuncAttributeMaxDynamicSharedMemorySize, LDS_BYTES) != hipSuccess) { fprintf(stderr, "kernel_launch: hipFuncSetAttribute failed\n"); grid = -1; return; }
        if (hipOccupancyMaxActiveBlocksPerMultiprocessor(&per_cu, (const void*)fwd_mega, NWAVES * 64, LDS_BYTES) != hipSuccess || per_cu < 1) per_cu = 1;
        (void)hipGetLastError();
        grid = cus * per_cu;
    }
    if (grid < 0) return;
    Args a{};
    for (int i = 0; i < 15; ++i) a.in[i] = (const float*)d_in[i];
    a.out = (float*)d_out; a.ws = (unsigned char*)d_ws;
    if (hipMemsetAsync((char*)d_ws + WS_BAR, 0, BAR_BYTES, stream) != hipSuccess) { fprintf(stderr, "kernel_launch: memset failed\n"); return; }
    if (N_LAUNCHES == 1) {
        a.ph_lo = 0; a.ph_hi = 10; void* args[] = {&a};
        hipError_t e = hipLaunchCooperativeKernel((const void*)fwd_mega, dim3(grid), dim3(NWAVES * 64), args, LDS_BYTES, stream);
        if (e != hipSuccess) fprintf(stderr, "cooperative launch failed: %s (grid %d)\n", hipGetErrorString(e), grid);
    } else {
        for (int p = 0; p < 10; ++p) { a.ph_lo = p; a.ph_hi = p + 1; hipLaunchKernelGGL(fwd_mega, dim3(grid), dim3(NWAVES * 64), LDS_BYTES, stream, a); }
    }
}
```
